# Optimizing an MI355X kernel written in HIP

```python
import jax, jax.numpy as jnp
from jax import lax
import numpy as np

D_MODEL = 2048
BATCH = 1
SEQ = 8192
DEPTH = 1

N_HEADS = 8
N_KV_HEADS = 2
HEAD_DIM = 128
ATTN_WIDTH = N_HEADS * HEAD_DIM
IDX_HEADS = 16
IDX_DIM = 64
INDEX_TOPK = 256
Q_BLOCK = 128
CONV_WIDTH = 1024
CONV_K = 3
N_EXPERTS = 64
N_GROUPS = 8
TOPK_GROUPS = 4
TOP_K = 8
EXPERT_FF = 512
SHARED_FF = 512
ROUTED_SCALE = 2.5
EXPERT_BLOCK = 128
PLE_DIM = 256
LN_EPS = 1e-5
DEEPNORM_ALPHA = (2 * DEPTH) ** 0.25
DEEPNORM_BETA = (8 * DEPTH) ** -0.25

IN_SPLITS = (ATTN_WIDTH,
             N_KV_HEADS * HEAD_DIM,
             N_KV_HEADS * HEAD_DIM,
             IDX_HEADS * IDX_DIM,
             IDX_DIM,
             IDX_HEADS,
             CONV_WIDTH,
             CONV_WIDTH,
             CONV_WIDTH,
             D_MODEL,
             D_MODEL)
IN_WIDTH = sum(IN_SPLITS)
SPLIT_POINTS = tuple(int(s) for s in np.cumsum(IN_SPLITS)[:-1])

kernel_name = "hybrid_dsa_shortconv_moe_block"


def layer_norm(x, g, b):
    xf = x.astype(jnp.float32)
    mu = jnp.mean(xf, axis=-1, keepdims=True)
    xc = xf - mu
    var = jnp.mean(jnp.square(xc), axis=-1, keepdims=True)
    y = xc * lax.rsqrt(var + LN_EPS) * g.astype(jnp.float32) + b.astype(jnp.float32)
    return y.astype(x.dtype)


def dsa_attention(q, k, v, q_idx, k_idx, w_idx):
    B, L = q.shape[0], q.shape[1]
    topk = min(INDEX_TOPK, L // 4)
    n_qb = L // Q_BLOCK
    q = q.reshape(B, L, N_KV_HEADS, N_HEADS // N_KV_HEADS, HEAD_DIM)
    w_idx = w_idx * (IDX_HEADS ** -0.5 * IDX_DIM ** -0.5)
    key_pos = jnp.arange(L, dtype=jnp.int32)
    attn_scale = HEAD_DIM ** -0.5
    gather = jax.vmap(lambda t, i: t[i])

    def block(qb):
        t0 = qb * Q_BLOCK
        q_pos = t0 + jnp.arange(Q_BLOCK, dtype=jnp.int32)
        qi = lax.dynamic_slice_in_dim(q_idx, t0, Q_BLOCK, axis=1)
        wi = lax.dynamic_slice_in_dim(w_idx, t0, Q_BLOCK, axis=1)
        rel = jax.nn.relu(jnp.einsum('bqhd,bsd->bqhs', qi, k_idx))
        score = jnp.einsum('bqhs,bqh->bqs', rel, wi).astype(jnp.float32)
        causal = key_pos[None, :] <= q_pos[:, None]
        score = jnp.where(causal[None], score, -jnp.inf)
        _, sel = lax.top_k(score, topk)
        valid = sel <= q_pos[None, :, None]
        kg = gather(k, sel)
        vg = gather(v, sel)
        qq = lax.dynamic_slice_in_dim(q, t0, Q_BLOCK, axis=1)
        logits = jnp.einsum('bqhgd,bqnhd->bqhgn', qq, kg).astype(jnp.float32) * attn_scale
        logits = jnp.where(valid[:, :, None, None, :], logits, -jnp.inf)
        probs = jax.nn.softmax(logits, axis=-1).astype(vg.dtype)
        out = jnp.einsum('bqhgn,bqnhd->bqhgd', probs, vg)
        return out.reshape(B, Q_BLOCK, ATTN_WIDTH)

    out = lax.map(block, jnp.arange(n_qb, dtype=jnp.int32))
    return out.transpose(1, 0, 2, 3).reshape(B, L, ATTN_WIDTH)


def short_conv(u, w):
    return lax.conv_general_dilated(
        u, w[:, None, :].astype(u.dtype), window_strides=(1,),
        padding=[(CONV_K - 1, 0)], dimension_numbers=('NWC', 'WIO', 'NWC'),
        feature_group_count=u.shape[-1])


def moe(h, router_w, router_b, w_gate, w_up, w_down, ws_gate, ws_up, ws_down):
    B, L, D = h.shape
    T = B * L
    hf = h.reshape(T, D)
    scores = jax.nn.sigmoid((hf @ router_w).astype(jnp.float32))
    biased = scores + router_b.astype(jnp.float32)
    grp = biased.reshape(T, N_GROUPS, N_EXPERTS // N_GROUPS)
    grp_score = lax.top_k(grp, 2)[0].sum(-1)
    _, top_grp = lax.top_k(grp_score, TOPK_GROUPS)
    grp_mask = jnp.any(top_grp[..., None] == jnp.arange(N_GROUPS)[None, None, :], axis=1)
    expert_mask = jnp.repeat(grp_mask, N_EXPERTS // N_GROUPS, axis=-1)
    cand = jnp.where(expert_mask, biased, -jnp.inf)
    _, sel = lax.top_k(cand, TOP_K)
    gate = jnp.take_along_axis(scores, sel, axis=-1)
    gate = gate / jnp.sum(gate, axis=-1, keepdims=True) * ROUTED_SCALE
    A = T * TOP_K
    flat_e = sel.reshape(A).astype(jnp.int32)
    flat_t = jnp.repeat(jnp.arange(T, dtype=jnp.int32), TOP_K)
    flat_g = gate.reshape(A)
    order = jnp.argsort(flat_e)
    e_sorted = flat_e[order]
    counts = jnp.bincount(flat_e, length=N_EXPERTS).astype(jnp.int32)
    start = jnp.cumsum(counts) - counts
    padded = (counts + EXPERT_BLOCK - 1) // EXPERT_BLOCK * EXPERT_BLOCK
    padded_end = jnp.cumsum(padded)
    padded_start = padded_end - padded
    dest = padded_start[e_sorted] + jnp.arange(A, dtype=jnp.int32) - start[e_sorted]
    n_blocks = -(-A // EXPERT_BLOCK) + N_EXPERTS
    P = n_blocks * EXPERT_BLOCK
    buf_tok = jnp.zeros((P,), jnp.int32).at[dest].set(flat_t[order])
    buf_gate = jnp.zeros((P,), h.dtype).at[dest].set(flat_g[order].astype(h.dtype))
    block_start = jnp.arange(n_blocks, dtype=jnp.int32) * EXPERT_BLOCK
    block_expert = jnp.minimum(jnp.searchsorted(padded_end, block_start, side='right'),
                               N_EXPERTS - 1)

    def expert_block(b):
        rows = lax.dynamic_slice_in_dim(buf_tok, b * EXPERT_BLOCK, EXPERT_BLOCK)
        g = lax.dynamic_slice_in_dim(buf_gate, b * EXPERT_BLOCK, EXPERT_BLOCK)
        e = block_expert[b]
        xb = hf[rows]
        hid = jax.nn.silu(xb @ w_gate[e]) * (xb @ w_up[e])
        return (hid @ w_down[e]) * g[:, None]

    y = lax.map(expert_block, jnp.arange(n_blocks, dtype=jnp.int32))
    routed = jnp.zeros_like(hf).at[buf_tok].add(y.reshape(P, D))
    shared = (jax.nn.silu(hf @ ws_gate) * (hf @ ws_up)) @ ws_down
    return (routed + shared).reshape(B, L, D)


def setup_inputs(seed: int = 0) -> dict:
    key = jax.random.key(seed)
    ks = jax.random.split(key, 24)
    f32 = jnp.float32

    def nrm(k, shape, fan_in, scale=1.0):
        return jax.random.normal(k, shape, f32) * (scale * fan_in ** -0.5)

    x = jax.random.normal(ks[0], (BATCH, SEQ, D_MODEL), f32)
    p = jax.random.normal(ks[1], (DEPTH, BATCH, SEQ, PLE_DIM), f32)
    w_in = nrm(ks[2], (DEPTH, D_MODEL, IN_WIDTH), D_MODEL)
    conv_w = nrm(ks[3], (DEPTH, CONV_K, CONV_WIDTH), CONV_K)
    w_attn_out = nrm(ks[4], (DEPTH, ATTN_WIDTH, D_MODEL), ATTN_WIDTH)
    w_conv_out = nrm(ks[5], (DEPTH, CONV_WIDTH, D_MODEL), CONV_WIDTH)
    w_out = nrm(ks[6], (DEPTH, D_MODEL, D_MODEL), D_MODEL, DEEPNORM_BETA)
    ln1_g = 1.0 + 0.02 * jax.random.normal(ks[7], (DEPTH, D_MODEL), f32)
    ln1_b = 0.02 * jax.random.normal(ks[8], (DEPTH, D_MODEL), f32)
    router_w = nrm(ks[9], (DEPTH, D_MODEL, N_EXPERTS), D_MODEL)
    router_b = 0.01 * jax.random.normal(ks[10], (DEPTH, N_EXPERTS), f32)
    w_gate = nrm(ks[11], (DEPTH, N_EXPERTS, D_MODEL, EXPERT_FF), D_MODEL)
    w_up = nrm(ks[12], (DEPTH, N_EXPERTS, D_MODEL, EXPERT_FF), D_MODEL)
    w_down = nrm(ks[13], (DEPTH, N_EXPERTS, EXPERT_FF, D_MODEL), EXPERT_FF, DEEPNORM_BETA)
    ws_gate = nrm(ks[14], (DEPTH, D_MODEL, SHARED_FF), D_MODEL)
    ws_up = nrm(ks[15], (DEPTH, D_MODEL, SHARED_FF), D_MODEL)
    ws_down = nrm(ks[16], (DEPTH, SHARED_FF, D_MODEL), SHARED_FF, DEEPNORM_BETA)
    w_ple_gate = nrm(ks[17], (DEPTH, D_MODEL, D_MODEL), D_MODEL)
    w_ple_proj = nrm(ks[18], (DEPTH, PLE_DIM, D_MODEL), PLE_DIM, DEEPNORM_BETA)
    ln2_g = 1.0 + 0.02 * jax.random.normal(ks[19], (DEPTH, D_MODEL), f32)
    ln2_b = 0.02 * jax.random.normal(ks[20], (DEPTH, D_MODEL), f32)
    return {"x": x, "p": p, "w_in": w_in, "conv_w": conv_w, "w_attn_out": w_attn_out,
            "w_conv_out": w_conv_out, "w_out": w_out, "ln1_g": ln1_g, "ln1_b": ln1_b,
            "router_w": router_w, "router_b": router_b, "w_gate": w_gate, "w_up": w_up,
            "w_down": w_down, "ws_gate": ws_gate, "ws_up": ws_up, "ws_down": ws_down,
            "w_ple_gate": w_ple_gate, "w_ple_proj": w_ple_proj, "ln2_g": ln2_g, "ln2_b": ln2_b}


def reference(x, p, w_in, conv_w, w_attn_out, w_conv_out, w_out, ln1_g, ln1_b,
              router_w, router_b, w_gate, w_up, w_down, ws_gate, ws_up, ws_down,
              w_ple_gate, w_ple_proj, ln2_g, ln2_b):
    B, L, _ = x.shape
    h = x
    for i in range(DEPTH):
        z = h @ w_in[i]
        (q, k, v, q_idx, k_idx, w_idx, c_b, c_c, c_h, g_attn, g_conv) = jnp.split(
            z, SPLIT_POINTS, axis=-1)
        y_attn = dsa_attention(
            q.reshape(B, L, N_HEADS, HEAD_DIM),
            k.reshape(B, L, N_KV_HEADS, HEAD_DIM),
            v.reshape(B, L, N_KV_HEADS, HEAD_DIM),
            q_idx.reshape(B, L, IDX_HEADS, IDX_DIM), k_idx, w_idx)
        y_conv = c_b * short_conv(c_c * c_h, conv_w[i])
        merged = (jax.nn.sigmoid(g_attn) * (y_attn @ w_attn_out[i])
                  + jax.nn.sigmoid(g_conv) * (y_conv @ w_conv_out[i]))
        h = layer_norm(DEEPNORM_ALPHA * h + merged @ w_out[i], ln1_g[i], ln1_b[i])
        ffn = moe(h, router_w[i], router_b[i], w_gate[i], w_up[i], w_down[i],
                  ws_gate[i], ws_up[i], ws_down[i])
        ple = jax.nn.sigmoid(h @ w_ple_gate[i]) * (p[i] @ w_ple_proj[i])
        h = layer_norm(DEEPNORM_ALPHA * h + ffn + ple, ln2_g[i], ln2_b[i])
    return h
```

```cpp
#include <hip/hip_runtime.h>
#include <cstdio>
#include <cstdint>

#ifndef MK_N_LAUNCHES
#define MK_N_LAUNCHES 1
#endif

#define GAS __attribute__((address_space(1)))
#define LAS __attribute__((address_space(3)))
typedef unsigned short bf16_t;
typedef short bf16x8 __attribute__((ext_vector_type(8)));
typedef float f32x4 __attribute__((ext_vector_type(4)));
typedef float f32x2 __attribute__((ext_vector_type(2)));
typedef unsigned u32x4 __attribute__((ext_vector_type(4)));
typedef unsigned u32x2 __attribute__((ext_vector_type(2)));
typedef long l64x2 __attribute__((ext_vector_type(2)));
typedef int i32x4 __attribute__((ext_vector_type(4)));
typedef int i32x8 __attribute__((ext_vector_type(8)));

constexpr int T = 8192, D = 2048;
constexpr int NH = 8, NKV = 2, HD = 128, AW = 1024;
constexpr int IH = 16, IDIM = 64, TOPK = 256;
constexpr int CW = 1024;
constexpr int NE = 64, EFF = 512, PLE = 256;
constexpr int IN_W = 9808;
constexpr int NIN_PAD = 9984;
constexpr float LN_EPS = 1e-5f;
constexpr float ALPHA = 1.189207115002721f;
constexpr int NWAVES = 8, NTHR = 512;

constexpr size_t MiB = 1u << 20;
constexpr size_t WS_CTL = 0, CTL_BYTES = 1 * MiB;
constexpr size_t WS_WIN = 1 * MiB;
constexpr size_t WS_WA = WS_WIN + 39 * MiB;
constexpr size_t WS_WB = WS_WA + 4 * MiB;
constexpr size_t WS_WO = WS_WB + 4 * MiB;
constexpr size_t WS_WPG = WS_WO + 8 * MiB;
constexpr size_t WS_WPE = WS_WPG + 8 * MiB;
constexpr size_t WS_RT = WS_WPE + 1 * MiB;
constexpr size_t WS_XB = WS_RT + 1 * MiB;
constexpr size_t WS_W1 = WS_XB + 32 * MiB;
constexpr size_t WS_Y = 1 * MiB;
constexpr size_t WS_W2 = WS_W1 + 260 * MiB;
static_assert(WS_Y + (size_t)90112 * 2048 * 2 <= WS_W2, "Y overlay");
constexpr size_t WS_Q = WS_W2 + 130 * MiB;
constexpr size_t WS_K = WS_Q + 16 * MiB;
constexpr size_t WS_V = WS_K + 4 * MiB;
constexpr size_t WS_QI = WS_V + 4 * MiB;
constexpr size_t WS_MISC = WS_QI + 16 * MiB;
constexpr size_t WS_WI = WS_MISC + 4 * MiB;
constexpr size_t WS_CB = WS_WI + 1 * MiB;
constexpr size_t WS_CC = WS_CB + 16 * MiB;
constexpr size_t WS_CH = WS_CC + 16 * MiB;
constexpr size_t WS_SA = WS_CH + 16 * MiB;
constexpr size_t WS_SB = WS_SA + 32 * MiB;
constexpr size_t WS_M1 = WS_SB + 32 * MiB;
constexpr size_t WS_H18 = WS_Q;
constexpr size_t WS_HID = WS_SA;
constexpr size_t WS_MG = WS_M1 + 32 * MiB;
constexpr size_t WS_PP = WS_MG + 32 * MiB;
constexpr size_t WS_PB = WS_PP + 32 * MiB;
constexpr size_t WS_YC = WS_PB + 4 * MiB;
constexpr size_t WS_SEL = WS_YC + 16 * MiB;
constexpr size_t WS_YA = WS_SEL + 8 * MiB;
constexpr size_t WS_PRE1 = WS_YA + 16 * MiB;
constexpr size_t WS_ACC2 = WS_PRE1;
constexpr size_t WS_H1F = WS_PRE1 + 64 * MiB;
constexpr size_t WS_H1B = WS_H1F + 64 * MiB;
constexpr size_t WS_TOKL = WS_H1B + 32 * MiB;
constexpr size_t WS_SLOT = WS_TOKL + 2 * MiB;
constexpr size_t WS_GATE = WS_SLOT + 1 * MiB;
constexpr size_t WS_END = WS_GATE + 1 * MiB;
static_assert(WS_END <= 1000 * MiB, "workspace map");

constexpr int CW_CNT = 64;
constexpr int CW_BAR = 4096;

constexpr int RING_BYTES = 131072;
constexpr int LDS_AUX = RING_BYTES;
constexpr int AUX_BYTES = 16384 + 1024;
constexpr int LDS_MISC = LDS_AUX + AUX_BYTES;
constexpr int LDS_BYTES = LDS_MISC + 256;

__device__ __forceinline__ unsigned f2bf(float f) { unsigned u = __builtin_bit_cast(unsigned, f); return (u + 0x7fffu + ((u >> 16) & 1u)) >> 16; }
__device__ __forceinline__ float bf2f(unsigned b) { return __builtin_bit_cast(float, b << 16); }
__device__ __forceinline__ float u2f(unsigned u) { return __builtin_bit_cast(float, u); }
__device__ __forceinline__ unsigned f2u(float f) { return __builtin_bit_cast(unsigned, f); }
__device__ __forceinline__ float bflo(unsigned w) { return __builtin_bit_cast(float, w << 16); }
__device__ __forceinline__ float bfhi(unsigned w) { return __builtin_bit_cast(float, w & 0xffff0000u); }
__device__ __forceinline__ unsigned cvt_pk_bf16(float lo, float hi) { unsigned r; asm volatile("v_cvt_pk_bf16_f32 %0, %1, %2" : "=v"(r) : "v"(lo), "v"(hi)); return r; }
__device__ __forceinline__ unsigned pk4_fp8(float a, float b, float c, float d) {
    int r = __builtin_amdgcn_cvt_pk_fp8_f32(a, b, 0, false); r = __builtin_amdgcn_cvt_pk_fp8_f32(c, d, r, true); return (unsigned)r; }
constexpr float W8_SCALE = 64.0f, W8_INV = 1.0f / 64.0f, Y8_SCALE = 16.0f, Y8_INV = 1.0f / 16.0f;
__device__ __forceinline__ float fast_sigmoid(float x) { return __builtin_amdgcn_rcpf(1.0f + __builtin_amdgcn_exp2f(-1.4426950408889634f * x)); }
#define LDS_WAIT() asm volatile("s_waitcnt lgkmcnt(0)" ::: "memory")
__device__ __forceinline__ unsigned lds_add(LAS unsigned* p, unsigned v) { return __hip_atomic_fetch_add(p, v, __ATOMIC_RELAXED, __HIP_MEMORY_SCOPE_WORKGROUP); }
__device__ __forceinline__ void lds_min(LAS unsigned* p, unsigned v) { (void)__hip_atomic_fetch_min(p, v, __ATOMIC_RELAXED, __HIP_MEMORY_SCOPE_WORKGROUP); }
__device__ __forceinline__ void lds_max(LAS unsigned* p, unsigned v) { (void)__hip_atomic_fetch_max(p, v, __ATOMIC_RELAXED, __HIP_MEMORY_SCOPE_WORKGROUP); }
__device__ __forceinline__ void lds_addf(LAS float* p, float v) { (void)__hip_atomic_fetch_add(p, v, __ATOMIC_RELAXED, __HIP_MEMORY_SCOPE_WORKGROUP); }
#define VM_WAIT() asm volatile("s_waitcnt vmcnt(0)" ::: "memory")

#define XB_TMO      128
#define XB_XCNT(j)  (256  + 64 * (j))
#define XB_XSUB(j)  (1280 + 64 * (j))
#define XB_XGEN(j)  (2304 + 64 * (j))
#define XB_TOP      3328
#define XB_TOPGEN   3392
#define XCD_BAR_WORDS 3456
#define XB_SPIN_CAP (1u << 18)
__device__ __forceinline__ unsigned xb_ld(unsigned* p)              { return __hip_atomic_load(p, __ATOMIC_RELAXED, __HIP_MEMORY_SCOPE_AGENT); }
__device__ __forceinline__ unsigned xb_add(unsigned* p, unsigned v) { return __hip_atomic_fetch_add(p, v, __ATOMIC_RELAXED, __HIP_MEMORY_SCOPE_AGENT); }
__device__ __forceinline__ unsigned xb_xcc_id() { return (unsigned)__builtin_amdgcn_s_getreg((3 << 11) | 20) & 0xFu; }
#define XB_SPIN(cond, bar) do { unsigned _sp = 0; while (cond) { __builtin_amdgcn_s_sleep(1); \
    if ((++_sp & 255u) == 0u) { if (xb_ld(&(bar)[XB_TMO])) break; if (_sp > XB_SPIN_CAP) { atomicAdd(&(bar)[XB_TMO], 1u); break; } } } } while (0)
struct XcdBarrier { unsigned* bar; unsigned x; volatile LAS unsigned* st; };
__device__ __forceinline__ XcdBarrier xcd_barrier_post(unsigned* bar, volatile LAS unsigned* st) {
    XcdBarrier b; b.bar = bar; b.x = xb_xcc_id(); b.st = st;
    if (threadIdx.x == 0) (void)xb_add(&bar[XB_XCNT(b.x)], 1u);
    return b;
}
__device__ __forceinline__ void xcd_barrier_complete(unsigned* bar, unsigned x, unsigned& nloc, unsigned& nx) {
    const unsigned G = gridDim.x * gridDim.y * gridDim.z;
    unsigned sum, cnt, mine, sp = 0u;
    for (;;) {
        sum = 0u; cnt = 0u; mine = 0u;
#pragma unroll
        for (unsigned j = 0; j < 16; ++j) { const unsigned c = xb_ld(&bar[XB_XCNT(j)]); sum += c; cnt += (c > 0u) ? 1u : 0u; mine = (j == x) ? c : mine; }
        if (sum == G) break;
        __builtin_amdgcn_s_sleep(1);
        if ((++sp & 255u) == 0u) { if (xb_ld(&bar[XB_TMO])) break; if (sp > XB_SPIN_CAP) { atomicAdd(&bar[XB_TMO], 1u); break; } }
    }
    nloc = mine > 0u ? mine : 1u; nx = cnt > 0u ? cnt : 1u;
}
__device__ __forceinline__ void xcd_barrier(const XcdBarrier& b) {
    asm volatile("s_waitcnt vmcnt(0)" ::: "memory");
    __syncthreads();
    if (threadIdx.x == 0) {
        unsigned* bar = b.bar;
        __builtin_amdgcn_s_waitcnt(0);
        unsigned nloc = b.st[0], nx = b.st[1];
        if (nloc == 0u) { xcd_barrier_complete(bar, b.x, nloc, nx); b.st[0] = nloc; b.st[1] = nx; }
        const unsigned old = xb_add(&bar[XB_XSUB(b.x)], 1u);
        const unsigned gen = old / nloc;
        if (old + 1u == (gen + 1u) * nloc) {
            __builtin_amdgcn_fence(__ATOMIC_RELEASE, "agent");
            asm volatile("s_waitcnt vmcnt(0)" ::: "memory");
            const unsigned og = xb_add(&bar[XB_TOP], 1u);
            const unsigned tg = og / nx;
            if (og + 1u == (tg + 1u) * nx) xb_add(&bar[XB_TOPGEN], 1u);
            else XB_SPIN(xb_ld(&bar[XB_TOPGEN]) == tg, bar);
            __builtin_amdgcn_fence(__ATOMIC_ACQUIRE, "agent");
            xb_add(&bar[XB_XGEN(b.x)], 1u);
            asm volatile("s_waitcnt vmcnt(0)" ::: "memory");
        } else {
            XB_SPIN(xb_ld(&bar[XB_XGEN(b.x)]) == gen, bar);
            __builtin_amdgcn_fence(__ATOMIC_ACQUIRE, "agent");
            asm volatile("s_waitcnt vmcnt(0)" ::: "memory");
        }
    }
    __syncthreads();
}

namespace pg8 {
constexpr int BM = 256, BK = 64, HALF = 128, HTB = HALF * BK * 2, STAGE_BYTES = 8 * HTB, NXCD = 8, WGM = 8;
__host__ __device__ __forceinline__ int lds_byte(int r, int c) { const int st = (r >> 4) * 2 + (c >> 5), rr = r & 15, cc = c & 31, ob = rr * 64 + cc * 2; return st * 1024 + (ob ^ (((ob >> 9) & 1) << 5)); }
__host__ __device__ __forceinline__ void stage_rc(int b, int& R, int& C) { const int st = b / 1024, sb = b % 1024, swz = sb ^ (((sb >> 9) & 1) << 5); R = (st >> 1) * 16 + swz / 64; C = (st & 1) * 32 + (swz % 64) / 2; }
__host__ __device__ __forceinline__ int perm32(int rho) { const int n = rho >> 4, i = rho & 15; return 8 * (i >> 2) + 4 * n + (i & 3); }

struct Unit { int pm, pn, e; };

struct DenseSched {
    const char* A; const char* Bt; int K; int rowb; int nM, nN, nwg, G, c;
    __device__ __forceinline__ void init(const void* A_, const void* Bt_, int M, int N, int K_, int G_, int c_) { A = (const char*)A_; Bt = (const char*)Bt_; K = K_; rowb = K_ * 2; nM = M / BM; nN = N / BM; nwg = nM * nN; G = G_; c = c_; }
    __device__ __forceinline__ bool next(int i, Unit& u) const {
        const long L = (long)i * G + c; if (L >= nwg) return false;
        int wgid = (int)L; { const int q = nwg / NXCD, r = nwg % NXCD, xcd = wgid % NXCD, off = wgid / NXCD; wgid = (xcd < r ? xcd * (q + 1) : r * (q + 1) + (xcd - r) * q) + off; }
        const int nig = WGM * nN, gid = wgid / nig, fm = gid * WGM, gsz = (nM - fm) < WGM ? (nM - fm) : WGM;
        u.pm = fm + ((wgid % nig) % gsz); u.pn = (wgid % nig) / gsz; u.e = 0; return true;
    }
    __device__ __forceinline__ const char* a_ptr(const Unit& u) const { return A + (size_t)u.pm * BM * rowb; }
    __device__ __forceinline__ const char* b_ptr(const Unit& u) const { return Bt + (size_t)u.pn * BM * rowb; }
    __device__ __forceinline__ void a_off(const Unit&, const int (&R)[2], const int (&C)[2], unsigned (&v)[2][2]) const {
#pragma unroll
        for (int h = 0; h < 2; ++h)
#pragma unroll
            for (int i = 0; i < 2; ++i) v[h][i] = (unsigned)((h * HALF + R[i]) * rowb + C[i] * 2);
    }
};

template <bool GATHER> struct MoeSched {
    const char* A; const char* Bt; size_t bstride; int K; int rowb; int npn; const LAS int* tstart; const int* cnt; const int* tokl; int total, G, c;
    __device__ __forceinline__ bool next(int i, Unit& u) const {
        const long L = (long)i * G + c; if (L >= total) return false;
        const int rt = (int)L / npn; u.pm = rt; u.pn = (int)L % npn;
        int lo = 0, hi = NE;
#pragma unroll
        for (int it = 0; it < 7; ++it) { const int mid = (lo + hi + 1) >> 1; if (tstart[mid] <= rt) lo = mid; else hi = mid - 1; }
        u.e = __builtin_amdgcn_readfirstlane(lo); u.pm = __builtin_amdgcn_readfirstlane(u.pm); u.pn = __builtin_amdgcn_readfirstlane(u.pn); return true;
    }
    __device__ __forceinline__ const char* a_ptr(const Unit& u) const { return GATHER ? A : A + (size_t)u.pm * BM * rowb; }
    __device__ __forceinline__ const char* b_ptr(const Unit& u) const { return Bt + (size_t)u.e * bstride + (size_t)u.pn * BM * rowb; }
    __device__ __forceinline__ void a_off(const Unit& u, const int (&R)[2], const int (&C)[2], unsigned (&v)[2][2]) const {
        if constexpr (GATHER) {
            const int base = (u.pm - tstart[u.e]) * BM; const int n = (u.e < NE) ? cnt[u.e] : T;
#pragma unroll
            for (int h = 0; h < 2; ++h)
#pragma unroll
                for (int i = 0; i < 2; ++i) { const int slot = base + h * HALF + R[i]; int tok = 0;
                    if (slot < n) tok = (u.e < NE) ? tokl[u.e * T + slot] : slot;
                    v[h][i] = (unsigned)(tok * rowb + C[i] * 2); }
        } else {
#pragma unroll
            for (int h = 0; h < 2; ++h)
#pragma unroll
                for (int i = 0; i < 2; ++i) v[h][i] = (unsigned)((h * HALF + R[i]) * rowb + C[i] * 2);
        }
    }
};

template <class Epi, class Sched, bool FP8 = false>
__device__ __forceinline__ void gemm_phase(LAS unsigned char* lds, const Sched& S, const Epi& E) {
    const int tid = threadIdx.x, wid = __builtin_amdgcn_readfirstlane(tid >> 6), lane = tid & 63, wr = wid >> 2, wc = wid & 3, fr = lane & 15, fq = lane >> 4;
    const int rowb = S.rowb, nt = rowb / (BK * 2);
    int R[2], C[2]; unsigned voffB[2];
#pragma unroll
    for (int i = 0; i < 2; ++i) { stage_rc(tid * 16 + i * 8192, R[i], C[i]); const int Rb = Epi::PERM ? ((R[i] & ~31) + perm32(R[i] & 31)) : R[i]; voffB[i] = (unsigned)(Rb * rowb + C[i] * 2); }
    const size_t kstep = (size_t)(BK * 2);
    const size_t hstep = (size_t)HALF * rowb;
    const unsigned ldsw = (unsigned)wid * 1024u;
    const int aoff = lds_byte(wr * 64 + fr, fq * 8), boff = lds_byte(wc * 32 + fr, fq * 8);
#define PG8_SA(b, h) (((b) * 2 + (h)) * HTB)
#define PG8_SB(b, h) ((4 + (b) * 2 + (h)) * HTB)
#define PG8_STAGE(bufoff, gbase, voff) do { _Pragma("unroll") for (int _i = 0; _i < 2; ++_i) \
        __builtin_amdgcn_global_load_lds((const unsigned*)((const char*)(gbase) + (voff)[_i]), (LAS unsigned*)(lds + (bufoff) + ldsw + _i * 8192), 16, 0, 0); } while (0)
#define PG8_LDA(dst, b, h) do { if constexpr (FP8) { _Pragma("unroll") for (int m = 0; m < 4; ++m) { const i32x4 x0_ = *(const LAS i32x4*)(lds + PG8_SA(b, h) + aoff + m * 2048), x1_ = *(const LAS i32x4*)(lds + PG8_SA(b, h) + aoff + m * 2048 + 1024); \
            dst##8[m] = __builtin_shufflevector(x0_, x1_, 0, 1, 2, 3, 4, 5, 6, 7); } } \
        else { _Pragma("unroll") for (int m = 0; m < 4; ++m) _Pragma("unroll") for (int k = 0; k < 2; ++k) dst[m][k] = *(const LAS bf16x8*)(lds + PG8_SA(b, h) + aoff + m * 2048 + k * 1024); } } while (0)
#define PG8_LDB(dst, b, h) do { if constexpr (FP8) { _Pragma("unroll") for (int n = 0; n < 2; ++n) { const i32x4 x0_ = *(const LAS i32x4*)(lds + PG8_SB(b, h) + boff + n * 2048), x1_ = *(const LAS i32x4*)(lds + PG8_SB(b, h) + boff + n * 2048 + 1024); \
            dst##8[n] = __builtin_shufflevector(x0_, x1_, 0, 1, 2, 3, 4, 5, 6, 7); } } \
        else { _Pragma("unroll") for (int n = 0; n < 2; ++n) _Pragma("unroll") for (int k = 0; k < 2; ++k) dst[n][k] = *(const LAS bf16x8*)(lds + PG8_SB(b, h) + boff + n * 2048 + k * 1024); } } while (0)
#define PG8_MMA(ai, bj, At, Bt) do { __builtin_amdgcn_s_setprio(1); _Pragma("unroll") for (int m = 0; m < 4; ++m) _Pragma("unroll") for (int n = 0; n < 2; ++n) { \
        if constexpr (FP8)   \
            asm("v_mfma_scale_f32_16x16x128_f8f6f4 %0, %1, %2, %0, %3, %3 op_sel_hi:[0,0,0]" : "+v"(acc[ai][bj][m][n]) : "v"(Bt##8[n]), "v"(At##8[m]), "v"(one_e8m0));   \
        else { _Pragma("unroll") for (int k = 0; k < 2; ++k) acc[ai][bj][m][n] = __builtin_amdgcn_mfma_f32_16x16x32_bf16(Bt[n][k], At[m][k], acc[ai][bj][m][n], 0, 0, 0); } } __builtin_amdgcn_s_setprio(0); } while (0)
#define PG8_WAIT_V(n) asm volatile("s_waitcnt vmcnt(" #n ")" ::: "memory")
#define PG8_WAIT_L(n) asm volatile("s_waitcnt lgkmcnt(" #n ")" ::: "memory")
#define PG8_BAR __builtin_amdgcn_s_barrier()
#define PG8_SCHED __builtin_amdgcn_sched_barrier(0)
    Unit cur, nxt; int ui = 0;
    if (!S.next(0, cur)) return;
    f32x4 acc[2][2][4][2];
#pragma unroll
    for (int a = 0; a < 2; ++a)
#pragma unroll
        for (int b = 0; b < 2; ++b)
#pragma unroll
            for (int m = 0; m < 4; ++m)
#pragma unroll
                for (int n = 0; n < 2; ++n) acc[a][b][m][n] = (f32x4){0.f, 0.f, 0.f, 0.f};
    bf16x8 At[4][2], B0[2][2], B1[2][2];
    i32x8 At8[4], B08[2], B18[2];
    const int one_e8m0 = 0x7F7F7F7F;
    unsigned cv[2][2], nv[2][2];
    S.a_off(cur, R, C, cv);
    const char* cA = S.a_ptr(cur); const char* cB = S.b_ptr(cur);
    PG8_STAGE(PG8_SB(0, 0), cB, voffB); PG8_STAGE(PG8_SB(0, 1), cB + hstep, voffB); PG8_STAGE(PG8_SA(0, 0), cA, cv[0]); PG8_STAGE(PG8_SA(0, 1), cA, cv[1]);
    if (wr == 1) PG8_BAR;
    PG8_WAIT_V(2); PG8_BAR;
    PG8_STAGE(PG8_SB(1, 0), cB + kstep, voffB); PG8_STAGE(PG8_SA(1, 0), cA + kstep, cv[0]); PG8_STAGE(PG8_SB(1, 1), cB + hstep + kstep, voffB);
    PG8_WAIT_V(6); PG8_BAR;
    for (;;) {
        const bool has_next = S.next(ui + 1, nxt);
        const char* nA = has_next ? S.a_ptr(nxt) : cA; const char* nB = has_next ? S.b_ptr(nxt) : cB;
        if (has_next) S.a_off(nxt, R, C, nv);
        else {
#pragma unroll
            for (int h = 0; h < 2; ++h)
#pragma unroll
                for (int i = 0; i < 2; ++i) nv[h][i] = cv[h][i]; }
        for (int t = 0; t < nt; t += 2) {
            const bool last = (t == nt - 2);
            const char* a1 = cA + (size_t)(t + 1) * kstep;
            const char* a2 = last ? nA : cA + (size_t)(t + 2) * kstep; const char* b2 = last ? nB : cB + (size_t)(t + 2) * kstep;
            const char* a3 = a2 + kstep; const char* b3 = b2 + kstep;
            unsigned v2[2][2];
#pragma unroll
            for (int h = 0; h < 2; ++h)
#pragma unroll
                for (int i = 0; i < 2; ++i) v2[h][i] = last ? nv[h][i] : cv[h][i];
            PG8_LDB(B0, 0, 0); PG8_LDB(B1, 0, 1); PG8_SCHED; PG8_LDA(At, 0, 0); PG8_STAGE(PG8_SA(1, 1), a1, cv[1]);
            PG8_WAIT_V(8); PG8_WAIT_L(0); PG8_BAR; PG8_MMA(0, 0, At, B0); PG8_MMA(0, 1, At, B1); PG8_BAR; PG8_SCHED;
            PG8_LDA(At, 0, 1); PG8_STAGE(PG8_SB(0, 0), b2, voffB); PG8_STAGE(PG8_SB(0, 1), b2 + hstep, voffB); PG8_STAGE(PG8_SA(0, 0), a2, v2[0]);
            PG8_WAIT_V(8); PG8_WAIT_L(0); PG8_BAR; PG8_MMA(1, 0, At, B0); PG8_MMA(1, 1, At, B1); PG8_BAR; PG8_SCHED;
            PG8_LDB(B0, 1, 0); PG8_LDB(B1, 1, 1); PG8_SCHED; PG8_LDA(At, 1, 0); PG8_STAGE(PG8_SA(0, 1), a2, v2[1]);
            PG8_WAIT_V(8); PG8_WAIT_L(0); PG8_BAR; PG8_MMA(0, 0, At, B0); PG8_MMA(0, 1, At, B1); PG8_BAR; PG8_SCHED;
            PG8_LDA(At, 1, 1); PG8_STAGE(PG8_SB(1, 0), b3, voffB); PG8_STAGE(PG8_SB(1, 1), b3 + hstep, voffB); PG8_STAGE(PG8_SA(1, 0), a3, v2[0]);
            PG8_WAIT_V(8); PG8_WAIT_L(0); PG8_BAR; PG8_MMA(1, 0, At, B0); PG8_MMA(1, 1, At, B1); PG8_BAR; PG8_SCHED;
        }
        if (wr == 0) PG8_BAR;
        E(acc, cur, wr, wc, fr, fq);
        if (!has_next) break;
#pragma unroll
        for (int a = 0; a < 2; ++a)
#pragma unroll
            for (int b = 0; b < 2; ++b)
#pragma unroll
                for (int m = 0; m < 4; ++m)
#pragma unroll
                    for (int n = 0; n < 2; ++n) acc[a][b][m][n] = (f32x4){0.f, 0.f, 0.f, 0.f};
        cur = nxt; cA = nA; cB = nB; ++ui;
#pragma unroll
        for (int h = 0; h < 2; ++h)
#pragma unroll
            for (int i = 0; i < 2; ++i) cv[h][i] = nv[h][i];
        if (wr == 1) PG8_BAR;
    }
    PG8_WAIT_V(0);
    PG8_BAR;
#undef PG8_SA
#undef PG8_SB
#undef PG8_STAGE
#undef PG8_LDA
#undef PG8_LDB
#undef PG8_MMA
#undef PG8_WAIT_V
#undef PG8_WAIT_L
#undef PG8_BAR
#undef PG8_SCHED
}
}
using pg8::Unit;

typedef const f32x4 (&AccRef)[2][2][4][2];

template <int ACT> __device__ __forceinline__ void store_tile_bf16(AccRef acc, bf16_t* O, int ld, size_t row0, int col0, int wr, int wc, int fr, int fq) {
#pragma unroll
    for (int ai = 0; ai < 2; ++ai)
#pragma unroll
        for (int m = 0; m < 4; ++m) { bf16_t* rowp = O + (row0 + ai * 128 + wr * 64 + m * 16 + fr) * (size_t)ld + col0 + wc * 32 + 8 * fq;
#pragma unroll
            for (int bj = 0; bj < 2; ++bj) { f32x4 v0 = acc[ai][bj][m][0], v1 = acc[ai][bj][m][1];
                if (ACT == 1) {
#pragma unroll
                    for (int j = 0; j < 4; ++j) { v0[j] = fast_sigmoid(v0[j]); v1[j] = fast_sigmoid(v1[j]); } }
                u32x4 w; w.x = cvt_pk_bf16(v0[0], v0[1]); w.y = cvt_pk_bf16(v0[2], v0[3]); w.z = cvt_pk_bf16(v1[0], v1[1]); w.w = cvt_pk_bf16(v1[2], v1[3]);
                *(u32x4*)(rowp + bj * 128) = w; } }
}

struct EpiInProj {
    static constexpr bool PERM = true;
    unsigned char* ws;
    __device__ __forceinline__ void operator()(AccRef acc, const Unit& u, int wr, int wc, int fr, int fq) const {
        const int pn = u.pn; const size_t row0 = (size_t)u.pm * 256;
        size_t boff; int ld, col0; bool sig = false;
        if (pn < 4) { boff = WS_Q; ld = AW; col0 = pn * 256; }
        else if (pn == 4) { boff = WS_K; ld = 256; col0 = 0; }
        else if (pn == 5) { boff = WS_V; ld = 256; col0 = 0; }
        else if (pn < 10) { boff = WS_QI; ld = 1024; col0 = (pn - 6) * 256; }
        else if (pn == 10) { boff = WS_MISC; ld = 256; col0 = 0; }
        else if (pn < 15) { boff = WS_CB; ld = CW; col0 = (pn - 11) * 256; }
        else if (pn < 19) { boff = WS_CC; ld = CW; col0 = (pn - 15) * 256; }
        else if (pn < 23) { boff = WS_CH; ld = CW; col0 = (pn - 19) * 256; }
        else if (pn < 31) { boff = WS_SA; ld = D; col0 = (pn - 23) * 256; sig = true; }
        else { boff = WS_SB; ld = D; col0 = (pn - 31) * 256; sig = true; }
        if (pn == 10) {
            if (wc < 2) { bf16_t* KIo = (bf16_t*)(ws + WS_MISC);
#pragma unroll
                for (int ai = 0; ai < 2; ++ai)
#pragma unroll
                    for (int m = 0; m < 4; ++m) { const f32x4 v0 = acc[ai][0][m][0], v1 = acc[ai][0][m][1];
                        u32x4 w; w.x = cvt_pk_bf16(v0[0], v0[1]); w.y = cvt_pk_bf16(v0[2], v0[3]); w.z = cvt_pk_bf16(v1[0], v1[1]); w.w = cvt_pk_bf16(v1[2], v1[3]);
                        const size_t key = row0 + ai * 128 + wr * 64 + m * 16 + fr;
                        *(u32x4*)(KIo + (((key >> 4) * 2 + wc) * 64 + fr + 16 * fq) * 8) = w; } }
        }
        else if (sig) store_tile_bf16<1>(acc, (bf16_t*)(ws + boff), ld, row0, col0, wr, wc, fr, fq);
        else store_tile_bf16<0>(acc, (bf16_t*)(ws + boff), ld, row0, col0, wr, wc, fr, fq);
        if (pn == 10 && wc == 2 && fq < 2) {
            float* WI = (float*)(ws + WS_WI);
#pragma unroll
            for (int ai = 0; ai < 2; ++ai)
#pragma unroll
                for (int m = 0; m < 4; ++m) { float* rp = WI + (row0 + ai * 128 + wr * 64 + m * 16 + fr) * 16 + 8 * fq;
                    *(f32x4*)(rp) = acc[ai][0][m][0] * 0.03125f; *(f32x4*)(rp + 4) = acc[ai][0][m][1] * 0.03125f; }
        }
    }
};
struct EpiPlain {
    static constexpr bool PERM = true;
    bf16_t* O; int ld;
    __device__ __forceinline__ void operator()(AccRef acc, const Unit& u, int wr, int wc, int fr, int fq) const {
        store_tile_bf16<0>(acc, O, ld, (size_t)u.pm * 256, u.pn * 256, wr, wc, fr, fq);
    }
};
struct EpiY8 {
    static constexpr bool PERM = true;
    unsigned char* O; float sc;
    __device__ __forceinline__ void operator()(AccRef acc, const Unit& u, int wr, int wc, int fr, int fq) const {
#pragma unroll
        for (int ai = 0; ai < 2; ++ai)
#pragma unroll
            for (int m = 0; m < 4; ++m) { unsigned char* rowp = O + ((size_t)u.pm * 256 + ai * 128 + wr * 64 + m * 16 + fr) * (size_t)D + u.pn * 256 + wc * 32 + 8 * fq;
#pragma unroll
                for (int bj = 0; bj < 2; ++bj) { const f32x4 v0 = acc[ai][bj][m][0] * sc, v1 = acc[ai][bj][m][1] * sc;
                    u32x2 w; w.x = pk4_fp8(v0[0], v0[1], v0[2], v0[3]); w.y = pk4_fp8(v1[0], v1[1], v1[2], v1[3]);
                    *(u32x2*)(rowp + bj * 128) = w; } }
    }
};
template <bool ADD> struct EpiGate {
    static constexpr bool PERM = true;
    const bf16_t* G; const bf16_t* P; bf16_t* O;
    __device__ __forceinline__ void operator()(AccRef acc, const Unit& u, int wr, int wc, int fr, int fq) const {
#pragma unroll
        for (int ai = 0; ai < 2; ++ai)
#pragma unroll
            for (int m = 0; m < 4; ++m) { const size_t off = ((size_t)u.pm * 256 + ai * 128 + wr * 64 + m * 16 + fr) * D + u.pn * 256 + wc * 32 + 8 * fq;
#pragma unroll
                for (int bj = 0; bj < 2; ++bj) { f32x4 v0 = acc[ai][bj][m][0], v1 = acc[ai][bj][m][1];
                    const u32x4 g = *(const u32x4*)(G + off + bj * 128);
                    v0[0] *= bflo(g.x); v0[1] *= bfhi(g.x); v0[2] *= bflo(g.y); v0[3] *= bfhi(g.y); v1[0] *= bflo(g.z); v1[1] *= bfhi(g.z); v1[2] *= bflo(g.w); v1[3] *= bfhi(g.w);
                    if (ADD) { const u32x4 p = *(const u32x4*)(P + off + bj * 128);
                        v0[0] += bflo(p.x); v0[1] += bfhi(p.x); v0[2] += bflo(p.y); v0[3] += bfhi(p.y); v1[0] += bflo(p.z); v1[1] += bfhi(p.z); v1[2] += bflo(p.w); v1[3] += bfhi(p.w); }
                    u32x4 w; w.x = cvt_pk_bf16(v0[0], v0[1]); w.y = cvt_pk_bf16(v0[2], v0[3]); w.z = cvt_pk_bf16(v1[0], v1[1]); w.w = cvt_pk_bf16(v1[2], v1[3]);
                    *(u32x4*)(O + off + bj * 128) = w; } }
    }
};
struct EpiResid {
    static constexpr bool PERM = false;
    const float* X; bf16_t* O;
    __device__ __forceinline__ void operator()(AccRef acc, const Unit& u, int wr, int wc, int fr, int fq) const {
#pragma unroll
        for (int ai = 0; ai < 2; ++ai)
#pragma unroll
            for (int m = 0; m < 4; ++m) { const size_t off = ((size_t)u.pm * 256 + ai * 128 + wr * 64 + m * 16 + fr) * D + u.pn * 256 + wc * 32 + 4 * fq;
#pragma unroll
                for (int bj = 0; bj < 2; ++bj)
#pragma unroll
                    for (int n = 0; n < 2; ++n) { const f32x4 x = *(const f32x4*)(X + off + bj * 128 + n * 16); const f32x4 r = x * ALPHA + acc[ai][bj][m][n];
                        u32x2 w; w.x = cvt_pk_bf16(r[0], r[1]); w.y = cvt_pk_bf16(r[2], r[3]); *(u32x2*)(O + off + bj * 128 + n * 16) = w; } }
    }
};
struct EpiPle {
    static constexpr bool PERM = false;
    const bf16_t* H; const bf16_t* PP; bf16_t* O;
    __device__ __forceinline__ void operator()(AccRef acc, const Unit& u, int wr, int wc, int fr, int fq) const {
#pragma unroll
        for (int ai = 0; ai < 2; ++ai)
#pragma unroll
            for (int m = 0; m < 4; ++m) { const size_t off = ((size_t)u.pm * 256 + ai * 128 + wr * 64 + m * 16 + fr) * D + u.pn * 256 + wc * 32 + 4 * fq;
#pragma unroll
                for (int bj = 0; bj < 2; ++bj)
#pragma unroll
                    for (int n = 0; n < 2; ++n) { const size_t o = off + bj * 128 + n * 16; const u32x2 h = *(const u32x2*)(H + o); const u32x2 p = *(const u32x2*)(PP + o);
                        const f32x4 a = acc[ai][bj][m][n]; f32x4 r;
                        r[0] = bflo(h.x) * ALPHA + fast_sigmoid(a[0]) * bflo(p.x); r[1] = bfhi(h.x) * ALPHA + fast_sigmoid(a[1]) * bfhi(p.x);
                        r[2] = bflo(h.y) * ALPHA + fast_sigmoid(a[2]) * bflo(p.y); r[3] = bfhi(h.y) * ALPHA + fast_sigmoid(a[3]) * bfhi(p.y);
                        u32x2 w; w.x = cvt_pk_bf16(r[0], r[1]); w.y = cvt_pk_bf16(r[2], r[3]); *(u32x2*)(O + o) = w; } }
    }
};
struct EpiSwiGlu {
    static constexpr bool PERM = true;
    unsigned char* HID;
    __device__ __forceinline__ void operator()(AccRef acc, const Unit& u, int wr, int wc, int fr, int fq) const {
#pragma unroll
        for (int ai = 0; ai < 2; ++ai)
#pragma unroll
            for (int m = 0; m < 4; ++m) { unsigned char* rowp = HID + ((size_t)u.pm * 256 + ai * 128 + wr * 64 + m * 16 + fr) * EFF + u.pn * 128 + wc * 32 + 8 * fq;
                f32x4 h0, h1;
#pragma unroll
                for (int j = 0; j < 4; ++j) { const float g0 = acc[ai][0][m][0][j] * W8_INV, g1 = acc[ai][0][m][1][j] * W8_INV;
                    h0[j] = g0 * fast_sigmoid(g0) * (acc[ai][1][m][0][j] * W8_INV); h1[j] = g1 * fast_sigmoid(g1) * (acc[ai][1][m][1][j] * W8_INV); }
                u32x2 w; w.x = pk4_fp8(h0[0], h0[1], h0[2], h0[3]); w.y = pk4_fp8(h1[0], h1[1], h1[2], h1[3]);
                *(u32x2*)rowp = w; }
    }
};

struct Args { const float* in[21]; float* out; unsigned char* ws; int ph_lo, ph_hi; };

__device__ __forceinline__ const float* karg(int i) { const float* p = ((const float* const*)__builtin_amdgcn_kernarg_segment_ptr())[i]; asm volatile("" : "+s"(p)); return p; }
struct Frame {
    LAS unsigned char* lds; int tid, lane, wave, G, vcu, gw, NGW;
    unsigned char* ws;
};

__device__ __forceinline__ void transpose_item(const float* src, int ldsrc, bf16_t* dst, int K, int nvalid, LAS float* scr, int lane) {
    if (nvalid > 0) {
#pragma unroll 8
        for (int i = 0; i < 32; ++i) { const int kk = 2 * i + (lane >> 5), n = lane & 31; scr[kk * 33 + n] = (n < nvalid) ? src[(size_t)kk * ldsrc + n] : 0.f; }
    } else {
#pragma unroll 8
        for (int i = 0; i < 32; ++i) { const int kk = 2 * i + (lane >> 5), n = lane & 31; scr[kk * 33 + n] = 0.f; }
    }
    LDS_WAIT(); asm volatile("" ::: "memory");
    const int c = lane & 7;
#pragma unroll
    for (int j = 0; j < 4; ++j) { const int n = (lane >> 3) + 8 * j; const LAS float* s = scr + (8 * c) * 33 + n;
        u32x4 o; o.x = cvt_pk_bf16(s[0 * 33], s[1 * 33]); o.y = cvt_pk_bf16(s[2 * 33], s[3 * 33]); o.z = cvt_pk_bf16(s[4 * 33], s[5 * 33]); o.w = cvt_pk_bf16(s[6 * 33], s[7 * 33]);
        *(u32x4*)(dst + (size_t)n * K + 8 * c) = o; }
    LDS_WAIT(); asm volatile("" ::: "memory");
}
__device__ __forceinline__ void router_item(const float* src, bf16_t* hi, bf16_t* lo, int k0, int n0, LAS float* scr, int lane) {
#pragma unroll 8
    for (int i = 0; i < 32; ++i) { const int kk = 2 * i + (lane >> 5), n = lane & 31; scr[kk * 33 + n] = src[(size_t)(k0 + kk) * NE + n0 + n]; }
    LDS_WAIT(); asm volatile("" ::: "memory");
    const int c = lane & 7;
#pragma unroll
    for (int j = 0; j < 4; ++j) { const int n = (lane >> 3) + 8 * j; const LAS float* s = scr + (8 * c) * 33 + n;
        float w[8], r[8]; unsigned h[8];
#pragma unroll
        for (int q = 0; q < 8; ++q) { w[q] = s[q * 33]; h[q] = f2bf(w[q]); r[q] = w[q] - bf2f(h[q]); }
        u32x4 oh, ol; oh.x = h[0] | (h[1] << 16); oh.y = h[2] | (h[3] << 16); oh.z = h[4] | (h[5] << 16); oh.w = h[6] | (h[7] << 16);
        ol.x = cvt_pk_bf16(r[0], r[1]); ol.y = cvt_pk_bf16(r[2], r[3]); ol.z = cvt_pk_bf16(r[4], r[5]); ol.w = cvt_pk_bf16(r[6], r[7]);
        *(u32x4*)(hi + (size_t)(n0 + n) * D + k0 + 8 * c) = oh; *(u32x4*)(lo + (size_t)(n0 + n) * D + k0 + 8 * c) = ol; }
    LDS_WAIT(); asm volatile("" ::: "memory");
}

struct CvtItem { const float* src; bf16_t* dst; int ldsrc, K, nvalid, fp8; };
__device__ __forceinline__ void cvt_load(const CvtItem& d, f32x4 (&r)[8], int lane) {
    const int nq = lane & 7, kq = lane >> 3;
    const float* p = d.src + (size_t)(8 * kq) * d.ldsrc + 4 * nq;
    const int nv = d.nvalid - 4 * nq;
#pragma unroll
    for (int i = 0; i < 8; ++i) { f32x4 v = (f32x4){0.f, 0.f, 0.f, 0.f}; if (nv >= 4) v = __builtin_nontemporal_load((const f32x4*)(p + (size_t)i * d.ldsrc)); r[i] = v; }
}
__device__ __forceinline__ void cvt_store(const CvtItem& d, const f32x4 (&r)[8], int lane) {
    const int nq = lane & 7, kq = lane >> 3;
    if (d.fp8) { unsigned char* o8 = (unsigned char*)d.dst + (size_t)(4 * nq) * d.K + 8 * kq;
#pragma unroll
        for (int c = 0; c < 4; ++c) { u32x2 w; w.x = pk4_fp8(r[0][c] * W8_SCALE, r[1][c] * W8_SCALE, r[2][c] * W8_SCALE, r[3][c] * W8_SCALE); w.y = pk4_fp8(r[4][c] * W8_SCALE, r[5][c] * W8_SCALE, r[6][c] * W8_SCALE, r[7][c] * W8_SCALE);
            __builtin_nontemporal_store(w, (u32x2*)(o8 + (size_t)c * d.K)); }
        return; }
    bf16_t* o = d.dst + (size_t)(4 * nq) * d.K + 8 * kq;
#pragma unroll
    for (int c = 0; c < 4; ++c) { u32x4 w; w.x = cvt_pk_bf16(r[0][c], r[1][c]); w.y = cvt_pk_bf16(r[2][c], r[3][c]); w.z = cvt_pk_bf16(r[4][c], r[5][c]); w.w = cvt_pk_bf16(r[6][c], r[7][c]);
        __builtin_nontemporal_store(w, (u32x4*)(o + (size_t)c * d.K)); }
}
constexpr int CV_I_IN = (NIN_PAD / 32) * (D / 64), CV_I_A = (D / 32) * (AW / 64), CV_I_O = (D / 32) * (D / 64), CV_I_PE = (D / 32) * (PLE / 64);
constexpr int CV_I_W1E = (1024 / 32) * (D / 64), CV_I_W2E = (D / 32) * (EFF / 64), CV_I_RT = (NE / 32) * (D / 64);
constexpr int CV_N0 = CV_I_IN, CV_N1 = CV_N0 + CV_I_A, CV_N2 = CV_N1 + CV_I_A, CV_N3 = CV_N2 + CV_I_O, CV_N4 = CV_N3 + CV_I_O, CV_N5 = CV_N4 + CV_I_PE, CV_N6 = CV_N5 + 65 * CV_I_W1E, CV_N7 = CV_N6 + 65 * CV_I_W2E;
__device__ __forceinline__ CvtItem cvt_desc(const Args& a, unsigned char* ws, int it) {
    CvtItem d; d.nvalid = 32; d.fp8 = 0;
    if (it < CV_N0) {
        const int db = it / (D / 64), kb = it % (D / 64); int sc;
        if (db < 80) sc = 32 * db; else if (db < 88) { sc = 2560 + 32 * (db - 80); int nv = 80 - 32 * (db - 80); d.nvalid = nv < 0 ? 0 : (nv > 32 ? 32 : nv); if (d.nvalid == 0) sc = 2560; } else sc = 2640 + 32 * (db - 88);
        d.src = karg(2) + (size_t)(64 * kb) * IN_W + sc; d.ldsrc = IN_W; d.dst = (bf16_t*)(ws + WS_WIN) + (size_t)(32 * db) * D + 64 * kb; d.K = D;
    } else if (it < CV_N2) {
        const bool second = it >= CV_N1; const int r = it - (second ? CV_N1 : CV_N0); const int db = r / (AW / 64), kb = r % (AW / 64);
        d.src = karg(second ? 5 : 4) + (size_t)(64 * kb) * D + 32 * db; d.ldsrc = D; d.dst = (bf16_t*)(ws + (second ? WS_WB : WS_WA)) + (size_t)(32 * db) * AW + 64 * kb; d.K = AW;
    } else if (it < CV_N4) {
        const bool second = it >= CV_N3; const int r = it - (second ? CV_N3 : CV_N2); const int db = r / (D / 64), kb = r % (D / 64);
        d.src = karg(second ? 17 : 6) + (size_t)(64 * kb) * D + 32 * db; d.ldsrc = D; d.dst = (bf16_t*)(ws + (second ? WS_WPG : WS_WO)) + (size_t)(32 * db) * D + 64 * kb; d.K = D;
    } else if (it < CV_N5) {
        const int r = it - CV_N4; const int db = r / (PLE / 64), kb = r % (PLE / 64);
        d.src = karg(18) + (size_t)(64 * kb) * D + 32 * db; d.ldsrc = D; d.dst = (bf16_t*)(ws + WS_WPE) + (size_t)(32 * db) * PLE + 64 * kb; d.K = PLE;
    } else if (it < CV_N6) {
        const int r = it - CV_N5; const int e = r / CV_I_W1E, q = r % CV_I_W1E; const int db = q / (D / 64), kb = q % (D / 64);
        const int ntile = db >> 3, within = (db & 7) * 32; const bool up = within >= 128; const int col = ntile * 128 + (up ? within - 128 : within);
        const float* src = (e < NE) ? (karg(up ? 12 : 11) + (size_t)e * D * EFF) : karg(up ? 15 : 14);
        d.src = src + (size_t)(64 * kb) * EFF + col; d.ldsrc = EFF; d.dst = (bf16_t*)(ws + WS_W1 + ((size_t)e * 1024 + 32 * db) * D + 64 * kb); d.K = D; d.fp8 = 1;
    } else {
        const int r = it - CV_N6; const int e = r / CV_I_W2E, q = r % CV_I_W2E; const int db = q / (EFF / 64), kb = q % (EFF / 64);
        const float* src = (e < NE) ? (karg(13) + (size_t)e * EFF * D) : karg(16);
        d.src = src + (size_t)(64 * kb) * D + 32 * db; d.ldsrc = D; d.dst = (bf16_t*)(ws + WS_W2 + ((size_t)e * D + 32 * db) * EFF + 64 * kb); d.K = EFF; d.fp8 = 1;
    }
    return d;
}
#ifndef NCONV
#define NCONV 48
#endif
#ifndef CONV_SHARE
#define CONV_SHARE 60
#endif
#ifndef CONV_FRAC_P2
#define CONV_FRAC_P2 70
#endif
constexpr int CV_P0_END = (NCONV > 0) ? CV_N5 + (int)((long)(CV_N7 - CV_N5) * (100 - CONV_SHARE) / 100) : CV_N7;
constexpr int CV_SPLIT = CV_P0_END + (int)((long)(CV_N7 - CV_P0_END) * CONV_FRAC_P2 / 100);
__device__ __forceinline__ void convert_range(const Args& a, unsigned char* ws, int i0, int i1, int cw, int ncw, int lane) {
    f32x4 r0[8], r1[8], r2[8], r3[8];
    CvtItem d0, d1, d2, d3;
    int it = i0 + cw;
    if (it >= i1) return;
    const int last = i1 - 1;
#define CV_LD(d, r, k) do { int j_ = it + (k) * ncw; d = cvt_desc(a, ws, j_ < i1 ? j_ : last); cvt_load(d, r, lane); } while (0)
    CV_LD(d0, r0, 0); CV_LD(d1, r1, 1); CV_LD(d2, r2, 2); CV_LD(d3, r3, 3);
#pragma unroll 1
    for (;;) {
        __builtin_amdgcn_sched_barrier(0);
        cvt_store(d0, r0, lane); it += ncw; if (it >= i1) break;
        __builtin_amdgcn_sched_barrier(0);
        CV_LD(d0, r0, 3);
        __builtin_amdgcn_sched_barrier(0);
        cvt_store(d1, r1, lane); it += ncw; if (it >= i1) break;
        __builtin_amdgcn_sched_barrier(0);
        CV_LD(d1, r1, 3);
        __builtin_amdgcn_sched_barrier(0);
        cvt_store(d2, r2, lane); it += ncw; if (it >= i1) break;
        __builtin_amdgcn_sched_barrier(0);
        CV_LD(d2, r2, 3);
        __builtin_amdgcn_sched_barrier(0);
        cvt_store(d3, r3, lane); it += ncw; if (it >= i1) break;
        __builtin_amdgcn_sched_barrier(0);
        CV_LD(d3, r3, 3);
    }
#undef CV_LD
}

__device__ __forceinline__ void phase_convert(const Frame& F, const Args& a) {
    LAS float* scr = (LAS float*)(F.lds + F.wave * 16384);
    unsigned char* ws = F.ws;
    convert_range(a, ws, 0, CV_P0_END, F.gw, F.NGW, F.lane);
    for (int r = F.gw; r < CV_I_RT; r += F.NGW) { const int db = r / (D / 64), kb = r % (D / 64);
        router_item(karg(9), (bf16_t*)(ws + WS_RT), (bf16_t*)(ws + WS_RT) + (size_t)NE * D, 64 * kb, 32 * db, scr, F.lane); }
    { const float* x = karg(0); bf16_t* xb = (bf16_t*)(ws + WS_XB); const size_t n8 = (size_t)T * D / 8;
      for (size_t i = (size_t)blockIdx.x * NTHR + F.tid; i < n8; i += (size_t)F.G * NTHR) { const f32x4 v0 = *(const f32x4*)(x + i * 8), v1 = *(const f32x4*)(x + i * 8 + 4);
          u32x4 w; w.x = cvt_pk_bf16(v0[0], v0[1]); w.y = cvt_pk_bf16(v0[2], v0[3]); w.z = cvt_pk_bf16(v1[0], v1[1]); w.w = cvt_pk_bf16(v1[2], v1[3]); *(u32x4*)(xb + i * 8) = w; } }
    { const float* p = karg(1); bf16_t* pb = (bf16_t*)(ws + WS_PB); const size_t n8 = (size_t)T * PLE / 8;
      for (size_t i = (size_t)blockIdx.x * NTHR + F.tid; i < n8; i += (size_t)F.G * NTHR) { const f32x4 v0 = *(const f32x4*)(p + i * 8), v1 = *(const f32x4*)(p + i * 8 + 4);
          u32x4 w; w.x = cvt_pk_bf16(v0[0], v0[1]); w.y = cvt_pk_bf16(v0[2], v0[3]); w.z = cvt_pk_bf16(v1[0], v1[1]); w.w = cvt_pk_bf16(v1[2], v1[3]); *(u32x4*)(pb + i * 8) = w; } }
}

#define DPP_XADD(v, ctrl) ((v) + u2f((unsigned)__builtin_amdgcn_update_dpp(0, (int)f2u(v), (ctrl), 0xF, 0xF, true)))
__device__ __forceinline__ float wave_sum(float v) {
    v = DPP_XADD(v, 0xB1);
    v = DPP_XADD(v, 0x4E);
    v = DPP_XADD(v, 0x141);
    v = DPP_XADD(v, 0x140);
    { const auto r = __builtin_amdgcn_permlane16_swap(f2u(v), f2u(v), false, false); const unsigned a = r[0], b = r[1]; v = u2f(a) + u2f(b); }
    { const auto r = __builtin_amdgcn_permlane32_swap(f2u(v), f2u(v), false, false); const unsigned a = r[0], b = r[1]; v = u2f(a) + u2f(b); }
    return v;
}

__device__ __forceinline__ void phase_yconv(const Frame& F, const float* conv_w, int wb, int wG) {
    const bf16_t* CB = (const bf16_t*)(F.ws + WS_CB); const bf16_t* CC = (const bf16_t*)(F.ws + WS_CC); const bf16_t* CH = (const bf16_t*)(F.ws + WS_CH); bf16_t* YC = (bf16_t*)(F.ws + WS_YC);
    const int total = T * (CW / 8);
    for (int idx = wb * NTHR + F.tid; idx < total; idx += wG * NTHR) {
        const int t = idx / (CW / 8), c = (idx % (CW / 8)) * 8;
        float accv[8];
#pragma unroll
        for (int j = 0; j < 8; ++j) accv[j] = 0.f;
#pragma unroll
        for (int d = 0; d < 3; ++d) { const int tt = t - 2 + d;
            if (tt >= 0) { const u32x4 cc = *(const u32x4*)(CC + (size_t)tt * CW + c), ch = *(const u32x4*)(CH + (size_t)tt * CW + c);
                const f32x4 w0 = *(const f32x4*)(conv_w + d * CW + c), w1 = *(const f32x4*)(conv_w + d * CW + c + 4);
                accv[0] += w0[0] * (bflo(cc.x) * bflo(ch.x)); accv[1] += w0[1] * (bfhi(cc.x) * bfhi(ch.x)); accv[2] += w0[2] * (bflo(cc.y) * bflo(ch.y)); accv[3] += w0[3] * (bfhi(cc.y) * bfhi(ch.y));
                accv[4] += w1[0] * (bflo(cc.z) * bflo(ch.z)); accv[5] += w1[1] * (bfhi(cc.z) * bfhi(ch.z)); accv[6] += w1[2] * (bflo(cc.w) * bflo(ch.w)); accv[7] += w1[3] * (bfhi(cc.w) * bfhi(ch.w)); } }
        const u32x4 cb = *(const u32x4*)(CB + (size_t)t * CW + c);
        u32x4 o; o.x = cvt_pk_bf16(accv[0] * bflo(cb.x), accv[1] * bfhi(cb.x)); o.y = cvt_pk_bf16(accv[2] * bflo(cb.y), accv[3] * bfhi(cb.y));
        o.z = cvt_pk_bf16(accv[4] * bflo(cb.z), accv[5] * bfhi(cb.z)); o.w = cvt_pk_bf16(accv[6] * bflo(cb.w), accv[7] * bfhi(cb.w));
        *(u32x4*)(YC + (size_t)t * CW + c) = o;
    }
}

__device__ __forceinline__ unsigned f2key(float f) { const unsigned u = __builtin_bit_cast(unsigned, f); return (u & 0x80000000u) ? ~u : (u | 0x80000000u); }
__device__ __forceinline__ float key2f(unsigned k) { const unsigned u = (k & 0x80000000u) ? (k & 0x7fffffffu) : ~k; return __builtin_bit_cast(float, u); }
constexpr int NBIN = 1024, CAND_CAP = 128;
struct RowState { unsigned kmin, kmax; float flo, scale; int bstar, cabove, cstar, need; unsigned ncand, nout, cmin, cmax; int done, level; unsigned cmin0, cmax0; };

__device__ __forceinline__ void phase_indexer(const Frame& F, int wb, int wG) {
    const bf16_t* QI = (const bf16_t*)(F.ws + WS_QI); const bf16_t* KI = (const bf16_t*)(F.ws + WS_MISC); const float* WI = (const float*)(F.ws + WS_WI); int* SEL = (int*)(F.ws + WS_SEL);
    LAS float* sc = (LAS float*)F.lds;
    LAS unsigned* hist = (LAS unsigned*)(F.lds + LDS_AUX);
    LAS RowState* rs = (LAS RowState*)(F.lds + LDS_AUX + 16384);
    const int lane = F.lane, wave = F.wave, fr = lane & 15, fq = lane >> 4;
    constexpr int NGRP = T / 4;
    for (int gi = wb; gi < NGRP + wG; gi += wG) {
        const int rnd = gi / wG, cidx = gi % wG; const int g = (rnd & 1) ? (rnd * wG + (wG - 1 - cidx)) : gi;
        if (g >= NGRP) continue;
        const int t0 = g * 4;
        if (t0 < 256) {
            for (int q = 0; q < 4; ++q) { const int t = t0 + q; for (int i = F.tid; i <= t; i += NTHR) SEL[(size_t)t * TOPK + i] = i; }
            continue;
        }
#ifdef PROBE_SEL_RECENT
        { for (int q = 0; q < 4; ++q) { const int t = t0 + q; for (int i = F.tid; i < TOPK; i += NTHR) SEL[(size_t)t * TOPK + i] = t - i; } continue; }
#endif
        const int nkeys = t0 + 4, ntile = (nkeys + 15) >> 4;
        if (F.tid < 4) { rs[F.tid].kmin = 0xffffffffu; rs[F.tid].kmax = 0u; }
        for (int i = F.tid; i < 4 * NBIN / 4; i += NTHR) ((LAS u32x4*)hist)[i] = (u32x4){0u, 0u, 0u, 0u};
        __syncthreads();
#ifdef PROBE_DOUBLE_SCORE
        for (int rep_ = 0; rep_ < 2; ++rep_)
#endif
        {
            bf16x8 aq[4][2]; float wq[4][4];
#pragma unroll
            for (int q = 0; q < 4; ++q) {
#pragma unroll
                for (int ks = 0; ks < 2; ++ks) aq[q][ks] = *(const bf16x8*)(QI + (size_t)(t0 + q) * 1024 + fr * 64 + ks * 32 + fq * 8);
                const f32x4 w4 = *(const f32x4*)(WI + (size_t)(t0 + q) * 16 + fq * 4);
#pragma unroll
                for (int j = 0; j < 4; ++j) wq[q][j] = 0.5f * w4[j];
            }
            float vmin = __builtin_inff(), vmax = -__builtin_inff();
            const int nmine = (ntile - wave + 7) >> 3;
            const int nchunk = (nmine + 3) >> 2;
            const int nslots = nchunk * 32; const int rot = (int)(((unsigned)wb * 37u + (unsigned)rnd * 11u) % (unsigned)nslots) & ~7;
#define IDX_KT(c, u) ({ int s_ = wave + 8 * (4 * (c) + (u)) + rot; s_ = s_ >= nslots ? s_ - nslots : s_; s_; })
#define IDX_LOAD(buf, c) do { _Pragma("unroll") for (int u_ = 0; u_ < 4; ++u_) { int kt2_ = IDX_KT(c, u_); kt2_ = kt2_ < T / 16 ? kt2_ : T / 16 - 1; \
                buf[u_][0] = *(const bf16x8*)(KI + ((size_t)(kt2_ * 2) * 64 + lane) * 8); buf[u_][1] = *(const bf16x8*)(KI + ((size_t)(kt2_ * 2 + 1) * 64 + lane) * 8); } } while (0)
#define IDX_COMPUTE(buf, c) do { f32x4 d_[4][4]; \
                _Pragma("unroll") for (int u_ = 0; u_ < 4; ++u_) _Pragma("unroll") for (int q_ = 0; q_ < 4; ++q_) { f32x4 z_ = (f32x4){0.f, 0.f, 0.f, 0.f}; \
                    z_ = __builtin_amdgcn_mfma_f32_16x16x32_bf16(aq[q_][0], buf[u_][0], z_, 0, 0, 0); d_[u_][q_] = __builtin_amdgcn_mfma_f32_16x16x32_bf16(aq[q_][1], buf[u_][1], z_, 0, 0, 0); } \
                _Pragma("unroll") for (int u_ = 0; u_ < 4; ++u_) { const int kt_ = IDX_KT(c, u_); float p_[4]; \
                    _Pragma("unroll") for (int q_ = 0; q_ < 4; ++q_) { const f32x4 x_ = d_[u_][q_]; \
                        p_[q_] = wq[q_][0] * (x_[0] + __builtin_fabsf(x_[0])) + wq[q_][1] * (x_[1] + __builtin_fabsf(x_[1])) + wq[q_][2] * (x_[2] + __builtin_fabsf(x_[2])) + wq[q_][3] * (x_[3] + __builtin_fabsf(x_[3])); } \
                    const auto r02_ = __builtin_amdgcn_permlane32_swap(f2u(p_[0]), f2u(p_[2]), false, false); const unsigned r020_ = r02_[0], r021_ = r02_[1]; \
                    const auto r13_ = __builtin_amdgcn_permlane32_swap(f2u(p_[1]), f2u(p_[3]), false, false); const unsigned r130_ = r13_[0], r131_ = r13_[1]; \
                    const float a_ = u2f(r020_) + u2f(r021_), b_ = u2f(r130_) + u2f(r131_); \
                    const auto rr_ = __builtin_amdgcn_permlane16_swap(f2u(a_), f2u(b_), false, false); const unsigned rr0_ = rr_[0], rr1_ = rr_[1]; \
                    const float tot_ = u2f(rr0_) + u2f(rr1_); \
                    const int key_ = kt_ * 16 + fr; if (key_ <= t0 + fq) { vmin = fminf(vmin, tot_); vmax = fmaxf(vmax, tot_); } \
                    if (kt_ < ntile) sc[fq * 8192 + key_] = tot_; } } while (0)
            bf16x8 bA[4][2], bB[4][2];
            IDX_LOAD(bA, 0);
            for (int c = 0; c < nchunk; c += 2) {
                __builtin_amdgcn_sched_barrier(0);
                IDX_LOAD(bB, c + 1);
                __builtin_amdgcn_sched_barrier(0);
                IDX_COMPUTE(bA, c);
#ifdef PROBE_COMPUTE2
                __builtin_amdgcn_sched_barrier(0);
                IDX_COMPUTE(bA, c);
#endif
                __builtin_amdgcn_sched_barrier(0);
                IDX_LOAD(bA, c + 2);
#ifdef PROBE_LOAD2
                __builtin_amdgcn_sched_barrier(0);
                { bf16x8 bC[4][2]; IDX_LOAD(bC, c + 3); asm volatile("" :: "v"(bC[0][0]), "v"(bC[1][0]), "v"(bC[2][0]), "v"(bC[3][0]), "v"(bC[0][1]), "v"(bC[1][1]), "v"(bC[2][1]), "v"(bC[3][1])); }
#endif
                __builtin_amdgcn_sched_barrier(0);
                IDX_COMPUTE(bB, c + 1);
#ifdef PROBE_COMPUTE2
                __builtin_amdgcn_sched_barrier(0);
                IDX_COMPUTE(bB, c + 1);
#endif
            }
#undef IDX_LOAD
#undef IDX_COMPUTE
#undef IDX_KT
            if (vmin <= vmax) { lds_min(&rs[fq].kmin, f2key(vmin)); lds_max(&rs[fq].kmax, f2key(vmax)); }
        }
        __syncthreads();
        const int q = wave >> 1, half = wave & 1, t = t0 + q, N = t + 1;
        const int sub = half * 64 + lane;
        LAS float* srow = sc + q * 8192;
        LAS unsigned* hrow = hist + q * NBIN;
        const int nit = (N + 511) >> 9;
        const unsigned long long ltmask = (1ull << lane) - 1ull;
#ifdef PROBE_DOUBLE_SEL
        for (int rep_ = 0; rep_ < 2; ++rep_) {
        if (rep_) { for (int i = sub; i < NBIN / 4; i += 128) ((LAS u32x4*)hrow)[i] = (u32x4){0u, 0u, 0u, 0u}; if (sub == 0) { rs[q].kmin = rs[q].cmin0; rs[q].kmax = rs[q].cmax0; } __syncthreads(); }
#endif
        int cur = half ? TOPK : 0;
        if (sub == 0) { rs[q].flo = key2f(rs[q].kmin); const float fhi0 = key2f(rs[q].kmax); const float rg = fhi0 - rs[q].flo; rs[q].scale = (rg > 0.f) ? (float)NBIN / rg : 0.f;
            rs[q].need = TOPK; rs[q].nout = 0u; rs[q].done = 0; rs[q].level = 0; rs[q].cmin = rs[q].kmin; rs[q].cmax = rs[q].kmax; rs[q].cmin0 = rs[q].kmin; rs[q].cmax0 = rs[q].kmax; rs[q].kmin = 0xffffffffu; rs[q].kmax = 0u; rs[q].ncand = 0u; }
        __syncthreads();
        for (int level = 0; level < 40; ++level) {
            const int alldone = rs[0].done & rs[1].done & rs[2].done & rs[3].done;
            if (alldone) break;
            const bool active = !rs[q].done;
            const float flo = rs[q].flo, scale = rs[q].scale; const float fhi = key2f(rs[q].cmax);
            const bool allsame = (rs[q].cmin == rs[q].cmax);
            if (level > 0) { for (int i = sub; i < NBIN / 4; i += 128) ((LAS u32x4*)hrow)[i] = (u32x4){0u, 0u, 0u, 0u}; __syncthreads(); }
            if (active && !allsame) {
                for (int it = 0; it < nit; ++it) { const int i0 = it * 512 + sub * 4; const f32x4 s4 = *(const LAS f32x4*)(srow + i0);
#pragma unroll
                    for (int e = 0; e < 4; ++e) { const float s = s4[e];
                        if (i0 + e < N && s >= flo && s <= fhi) { const int b = (int)fminf(fmaxf((s - flo) * scale, 0.f), (float)(NBIN - 1)); lds_add(&hrow[b], 1u); } } }
            }
            __syncthreads();
            if (active && !allsame && half == 0) {
                unsigned loc = 0;
#pragma unroll
                for (int j = 0; j < 4; ++j) { const u32x4 h4 = ((const LAS u32x4*)hrow)[lane * 4 + j]; loc += (h4.x + h4.y) + (h4.z + h4.w); }
                unsigned suf = loc;
#pragma unroll
                for (int o = 1; o < 64; o <<= 1) { const unsigned v = __shfl_down(suf, o); if (lane + o < 64) suf += v; }
                const unsigned above_lane = suf - loc; const unsigned need = (unsigned)rs[q].need;
                if (above_lane < need && suf >= need) {
                    unsigned ab = above_lane; int b = lane * 16 + 15;
                    for (;; --b) { const unsigned h = hrow[b]; if (ab + h >= need) { rs[q].bstar = b; rs[q].cabove = (int)ab; rs[q].cstar = (int)h; break; } ab += h; }
                }
            }
            __syncthreads();
            if (active) {
                if (allsame) {
                    if (half == 0) {
                        unsigned need = (unsigned)rs[q].need; unsigned base = (unsigned)cur;
                        for (int i0 = 0; i0 < N && need > 0; i0 += 64) { const int i = i0 + lane; const bool m = (i < N) && (srow[i] >= flo && srow[i] <= fhi);
                            const unsigned long long mask = __ballot(m); const unsigned pos = __builtin_popcountll(mask & ltmask);
                            if (m && pos < need) SEL[(size_t)t * TOPK + base + pos] = i;
                            const unsigned c = (unsigned)__builtin_popcountll(mask); const unsigned take = c < need ? c : need; base += take; need -= take; }
                        if (lane == 0) { rs[q].done = 1; }
                    }
                } else {
                    const int bstar = rs[q].bstar, cstar = rs[q].cstar; const bool collect = cstar <= CAND_CAP;
                    unsigned lmin = 0xffffffffu, lmax = 0u;
                    for (int it = 0; it < nit; ++it) { const int i0 = it * 512 + sub * 4; const f32x4 s4 = *(const LAS f32x4*)(srow + i0);
#pragma unroll
                        for (int e = 0; e < 4; ++e) { const float s = s4[e]; const int i = i0 + e; bool em = false, cd = false;
                            if (i < N && s >= flo && s <= fhi) { const int b = (int)fminf(fmaxf((s - flo) * scale, 0.f), (float)(NBIN - 1)); em = b > bstar; cd = b == bstar; }
                            const unsigned long long me = __ballot(em); const int ne = __builtin_popcountll(me); const int rk = __builtin_popcountll(me & ltmask);
                            if (em) SEL[(size_t)t * TOPK + (half ? (cur - 1 - rk) : (cur + rk))] = i;
                            cur = half ? cur - ne : cur + ne;
                            const unsigned long long mc = __ballot(cd);
                            if (mc) {
                                if (collect) { unsigned base = 0; if (lane == 0) base = lds_add(&rs[q].ncand, (unsigned)__builtin_popcountll(mc)); base = __shfl(base, 0);
                                    if (cd) { const unsigned p = base + __builtin_popcountll(mc & ltmask); hrow[p] = __builtin_bit_cast(unsigned, s); hrow[CAND_CAP + p] = (unsigned)i; } }
                                else if (cd) { const unsigned k = f2key(s); lmin = k < lmin ? k : lmin; lmax = k > lmax ? k : lmax; }
                            } } }
                    if (!collect && lmin <= lmax) { lds_min(&rs[q].kmin, lmin); lds_max(&rs[q].kmax, lmax); }
                    if (half == 0 && lane == 0) rs[q].nout = (unsigned)cur;
                }
            }
            __syncthreads();
            if (active && !allsame) {
                const int cstar = rs[q].cstar; const int need2 = rs[q].need - rs[q].cabove;
                if (cstar <= CAND_CAP) {
                    const unsigned nout = rs[q].nout;
                    for (int i = sub; i < cstar; i += 128) { const float s = __builtin_bit_cast(float, hrow[i]); const unsigned id = hrow[CAND_CAP + i]; int rank = 0;
                        for (int j = 0; j < cstar; ++j) { const float sj = __builtin_bit_cast(float, hrow[j]); const unsigned idj = hrow[CAND_CAP + j]; rank += (sj > s || (sj == s && idj < id)) ? 1 : 0; }
                        if (rank < need2) SEL[(size_t)t * TOPK + nout + rank] = (int)id; }
                }
            }
            __syncthreads();
            if (sub == 0 && active && !allsame) {
                if (rs[q].cstar <= CAND_CAP) rs[q].done = 1;
                else {
                    rs[q].need = rs[q].need - rs[q].cabove;
                    rs[q].cmin = rs[q].kmin; rs[q].cmax = rs[q].kmax;
                    const float nlo = key2f(rs[q].kmin), nhi = key2f(rs[q].kmax); rs[q].flo = nlo; const float rg = nhi - nlo; rs[q].scale = (rg > 0.f) ? (float)NBIN / rg : 0.f;
                    rs[q].kmin = 0xffffffffu; rs[q].kmax = 0u; rs[q].ncand = 0u;
                }
            }
            __syncthreads();
        }
#ifdef PROBE_DOUBLE_SEL
        __syncthreads(); }
#endif
        __syncthreads();
    }
}

__device__ __forceinline__ void phase_attn_simple(const Frame& F) {
    const bf16_t* Q = (const bf16_t*)(F.ws + WS_Q); const bf16_t* Kb = (const bf16_t*)(F.ws + WS_K); const bf16_t* Vb = (const bf16_t*)(F.ws + WS_V); const int* SEL = (const int*)(F.ws + WS_SEL);
    bf16_t* YA = (bf16_t*)(F.ws + WS_YA);
    LAS float* qs = (LAS float*)(F.lds + F.wave * 8192);
    LAS float* ps = qs + 512;
    const int lane = F.lane;
    const float scale = 0.08838834764831845f;
#pragma unroll 1
    for (int task = F.gw; task < T * NKV; task += F.NGW) {
        const int t = task >> 1, kvh = task & 1; const int nsel = (t + 1) < TOPK ? (t + 1) : TOPK;
#pragma unroll
        for (int i = 0; i < 8; ++i) { const int e = i * 64 + lane; qs[e] = bf2f(Q[(size_t)t * AW + kvh * 512 + e]); }
        LDS_WAIT(); asm volatile("" ::: "memory");
        float mx0 = -__builtin_inff(), mx1 = mx0, mx2 = mx0, mx3 = mx0;
#pragma unroll 1
        for (int s = 0; s < 4; ++s) {
            const int pos = s * 64 + lane; const bool valid = pos < nsel; const int key = valid ? SEL[(size_t)t * TOPK + pos] : 0;
            const bf16_t* kr = Kb + (size_t)key * 256 + kvh * 128;
            float a0 = 0.f, a1 = 0.f, a2 = 0.f, a3 = 0.f;
#pragma unroll 2
            for (int c = 0; c < 16; ++c) { const u32x4 kk = *(const u32x4*)(kr + c * 8);
                const float k0 = bflo(kk.x), k1 = bfhi(kk.x), k2 = bflo(kk.y), k3 = bfhi(kk.y), k4 = bflo(kk.z), k5 = bfhi(kk.z), k6 = bflo(kk.w), k7 = bfhi(kk.w);
#define DOT8(h, acc_) { const f32x4 qa = *(const LAS f32x4*)(qs + (h) * 128 + c * 8), qb = *(const LAS f32x4*)(qs + (h) * 128 + c * 8 + 4); \
                acc_ += qa[0] * k0 + qa[1] * k1 + qa[2] * k2 + qa[3] * k3 + qb[0] * k4 + qb[1] * k5 + qb[2] * k6 + qb[3] * k7; }
                DOT8(0, a0) DOT8(1, a1) DOT8(2, a2) DOT8(3, a3)
#undef DOT8
            }
            const float ninf = -__builtin_inff();
            a0 = valid ? a0 * scale : ninf; a1 = valid ? a1 * scale : ninf; a2 = valid ? a2 * scale : ninf; a3 = valid ? a3 * scale : ninf;
            mx0 = fmaxf(mx0, a0); mx1 = fmaxf(mx1, a1); mx2 = fmaxf(mx2, a2); mx3 = fmaxf(mx3, a3);
            *(LAS f32x4*)(ps + pos * 4) = (f32x4){a0, a1, a2, a3};
        }
#pragma unroll
        for (int o = 1; o < 64; o <<= 1) { mx0 = fmaxf(mx0, __shfl_xor(mx0, o)); mx1 = fmaxf(mx1, __shfl_xor(mx1, o)); mx2 = fmaxf(mx2, __shfl_xor(mx2, o)); mx3 = fmaxf(mx3, __shfl_xor(mx3, o)); }
        LDS_WAIT(); asm volatile("" ::: "memory");
        float s0 = 0.f, s1 = 0.f, s2 = 0.f, s3 = 0.f;
#pragma unroll 1
        for (int s = 0; s < 4; ++s) { const int pos = s * 64 + lane; f32x4 l = *(const LAS f32x4*)(ps + pos * 4);
            l[0] = __builtin_amdgcn_exp2f((l[0] - mx0) * 1.4426950408889634f); l[1] = __builtin_amdgcn_exp2f((l[1] - mx1) * 1.4426950408889634f);
            l[2] = __builtin_amdgcn_exp2f((l[2] - mx2) * 1.4426950408889634f); l[3] = __builtin_amdgcn_exp2f((l[3] - mx3) * 1.4426950408889634f);
            s0 += l[0]; s1 += l[1]; s2 += l[2]; s3 += l[3];
            *(LAS f32x4*)(ps + pos * 4) = l; }
        s0 = wave_sum(s0); s1 = wave_sum(s1); s2 = wave_sum(s2); s3 = wave_sum(s3);
#ifdef PROBE_ATTN_ZERO
        const float i0 = 0.f, i1 = 0.f, i2 = 0.f, i3 = 0.f; (void)s0; (void)s1; (void)s2; (void)s3;
#else
        const float i0 = 1.0f / s0, i1 = 1.0f / s1, i2 = 1.0f / s2, i3 = 1.0f / s3;
#endif
        LDS_WAIT(); asm volatile("" ::: "memory");
        float o00 = 0.f, o01 = 0.f, o10 = 0.f, o11 = 0.f, o20 = 0.f, o21 = 0.f, o30 = 0.f, o31 = 0.f;
#pragma unroll 1
        for (int n0 = 0; n0 < nsel; n0 += 8) {
            unsigned vv[8];
#pragma unroll
            for (int j = 0; j < 8; ++j) { const int key = (n0 + j < nsel) ? SEL[(size_t)t * TOPK + n0 + j] : 0; vv[j] = *(const unsigned*)(Vb + (size_t)key * 256 + kvh * 128 + 2 * lane); }
#pragma unroll
            for (int j = 0; j < 8; ++j) { const f32x4 p = *(const LAS f32x4*)(ps + (n0 + j) * 4); const float v0 = bflo(vv[j]), v1 = bfhi(vv[j]);
                o00 += p[0] * v0; o01 += p[0] * v1; o10 += p[1] * v0; o11 += p[1] * v1; o20 += p[2] * v0; o21 += p[2] * v1; o30 += p[3] * v0; o31 += p[3] * v1; } }
        bf16_t* yo = YA + (size_t)t * AW + kvh * 512 + 2 * lane;
        *(unsigned*)(yo) = cvt_pk_bf16(o00 * i0, o01 * i0); *(unsigned*)(yo + 128) = cvt_pk_bf16(o10 * i1, o11 * i1);
        *(unsigned*)(yo + 256) = cvt_pk_bf16(o20 * i2, o21 * i2); *(unsigned*)(yo + 384) = cvt_pk_bf16(o30 * i3, o31 * i3);
        LDS_WAIT(); asm volatile("" ::: "memory");
    }
}

typedef short s16x4 __attribute__((ext_vector_type(4)));
template <int OFF> __device__ __forceinline__ s16x4 tr_read(unsigned a) { s16x4 r; asm volatile("ds_read_b64_tr_b16 %0, %1 offset:%2" : "=&v"(r) : "v"(a), "i"(OFF) : "memory"); return r; }
__device__ __forceinline__ unsigned off_b(unsigned row, unsigned ch) { return 256u * row + 16u * (ch ^ (((row & 3u) << 2) | ((row >> 2) & 3u))); }

template <int BUF> __device__ __forceinline__ void attn_pv_step(f32x4 (&oacc)[8], const unsigned (&tra)[8][2], const bf16x8 pf) {
    s16x4 lo[8], hi[8];
#pragma unroll
    for (int c = 0; c < 8; ++c) { lo[c] = tr_read<BUF * 8192>(tra[c][0]); hi[c] = tr_read<BUF * 8192>(tra[c][1]); }
    asm volatile("s_waitcnt lgkmcnt(0)" ::: "memory"); __builtin_amdgcn_sched_barrier(0);
#pragma unroll
    for (int c = 0; c < 8; ++c) { const bf16x8 a = (bf16x8){lo[c][0], lo[c][1], lo[c][2], lo[c][3], hi[c][0], hi[c][1], hi[c][2], hi[c][3]};
        oacc[c] = __builtin_amdgcn_mfma_f32_16x16x32_bf16(a, pf, oacc[c], 0, 0, 0); }
}

__device__ __forceinline__ void phase_attn_mfma(const Frame& F, int wb, int wG) {
    const bf16_t* Q = (const bf16_t*)(F.ws + WS_Q); const bf16_t* Kb = (const bf16_t*)(F.ws + WS_K); const bf16_t* Vb = (const bf16_t*)(F.ws + WS_V); const int* SEL = (const int*)(F.ws + WS_SEL);
    bf16_t* YA = (bf16_t*)(F.ws + WS_YA);
    const int lane = F.lane, fr = lane & 15, fq = lane >> 4;
    LAS unsigned char* wl = F.lds + F.wave * 16384;
    LAS int* selw = (LAS int*)(F.lds + LDS_AUX + F.wave * 1024);
    const unsigned wl_addr = (unsigned)(size_t)wl;
    unsigned tra[8][2];
    { const unsigned g = fq, q = (lane & 15) >> 2, p = lane & 3;
#pragma unroll
      for (int c = 0; c < 8; ++c)
#pragma unroll
          for (int t2 = 0; t2 < 2; ++t2) tra[c][t2] = wl_addr + off_b(8 * g + 4 * t2 + q, 2 * c + (p >> 1)) + 8 * (p & 1); }
    const float c2 = 0.08838834764831845f * 1.4426950408889634f;
#pragma unroll 1
    for (int task = wb * NWAVES + F.wave; task < T * NKV; task += wG * NWAVES) {
        const int t = task >> 1, kvh = task & 1; const int nsel = (t + 1) < TOPK ? (t + 1) : TOPK;
#pragma unroll
        for (int i = 0; i < 4; ++i) { const int pos = i * 64 + lane; selw[pos] = (pos < nsel) ? SEL[(size_t)t * TOPK + pos] : 0; }
        LDS_WAIT(); asm volatile("" ::: "memory");
        const bf16_t* Vh = Vb + kvh * 128; const bf16_t* Kh = Kb + kvh * 128;
#define ATTN_DMA(ks, buf) do { _Pragma("unroll") for (int i_ = 0; i_ < 8; ++i_) { const int row_ = 4 * i_ + fq; const int key_ = selw[(ks) * 32 + row_]; \
            const unsigned ch_ = (unsigned)fr ^ ((((unsigned)row_ & 3u) << 2) | (((unsigned)row_ >> 2) & 3u)); \
            __builtin_amdgcn_global_load_lds((const unsigned*)(Vh + (size_t)key_ * 256 + ch_ * 8), (LAS unsigned*)(wl + (buf) * 8192 + i_ * 1024), 16, 0, 0); } } while (0)
        ATTN_DMA(0, 0); ATTN_DMA(1, 1);
        bf16x8 qf[4];
#pragma unroll
        for (int ks = 0; ks < 4; ++ks) { qf[ks] = (bf16x8){0, 0, 0, 0, 0, 0, 0, 0}; if (fr < 4) qf[ks] = *(const bf16x8*)(Q + (size_t)t * AW + (kvh * 4 + fr) * 128 + ks * 32 + fq * 8); }
        f32x4 sacc[16];
#pragma unroll
        for (int tt = 0; tt < 16; ++tt) {
            const int pos = 32 * (tt >> 1) + 8 * (fr >> 2) + 4 * (tt & 1) + (fr & 3);
            const int key = selw[pos];
            const bf16_t* kr = Kh + (size_t)key * 256 + fq * 8;
            const bf16x8 k0 = *(const bf16x8*)(kr), k1 = *(const bf16x8*)(kr + 32), k2 = *(const bf16x8*)(kr + 64), k3 = *(const bf16x8*)(kr + 96);
            f32x4 d = (f32x4){0.f, 0.f, 0.f, 0.f};
            d = __builtin_amdgcn_mfma_f32_16x16x32_bf16(k0, qf[0], d, 0, 0, 0);
            d = __builtin_amdgcn_mfma_f32_16x16x32_bf16(k1, qf[1], d, 0, 0, 0);
            d = __builtin_amdgcn_mfma_f32_16x16x32_bf16(k2, qf[2], d, 0, 0, 0);
            d = __builtin_amdgcn_mfma_f32_16x16x32_bf16(k3, qf[3], d, 0, 0, 0);
            sacc[tt] = d;
        }
        float m = -__builtin_inff();
#pragma unroll
        for (int tt = 0; tt < 16; ++tt)
#pragma unroll
            for (int j = 0; j < 4; ++j) { const int pos = 32 * (tt >> 1) + 8 * fq + 4 * (tt & 1) + j; const float v = (pos < nsel) ? sacc[tt][j] : -__builtin_inff(); sacc[tt][j] = v; m = fmaxf(m, v); }
        m = fmaxf(m, __shfl_xor(m, 16)); m = fmaxf(m, __shfl_xor(m, 32));
        float sum = 0.f; const float mc = m * c2;
#pragma unroll
        for (int tt = 0; tt < 16; ++tt)
#pragma unroll
            for (int j = 0; j < 4; ++j) { const float p = __builtin_amdgcn_exp2f(sacc[tt][j] * c2 - mc); sacc[tt][j] = p; sum += p; }
        sum += __shfl_xor(sum, 16); sum += __shfl_xor(sum, 32);
        const float inv = 1.0f / sum;
        bf16x8 pf[8];
#pragma unroll
        for (int ks = 0; ks < 8; ++ks) { u32x4 w; w.x = cvt_pk_bf16(sacc[2 * ks][0], sacc[2 * ks][1]); w.y = cvt_pk_bf16(sacc[2 * ks][2], sacc[2 * ks][3]);
            w.z = cvt_pk_bf16(sacc[2 * ks + 1][0], sacc[2 * ks + 1][1]); w.w = cvt_pk_bf16(sacc[2 * ks + 1][2], sacc[2 * ks + 1][3]); pf[ks] = __builtin_bit_cast(bf16x8, w); }
        f32x4 oacc[8];
#pragma unroll
        for (int c = 0; c < 8; ++c) oacc[c] = (f32x4){0.f, 0.f, 0.f, 0.f};
#pragma unroll
        for (int ks = 0; ks < 8; ++ks) {
            if (ks < 7) asm volatile("s_waitcnt vmcnt(8)" ::: "memory"); else asm volatile("s_waitcnt vmcnt(0)" ::: "memory");
            if (ks & 1) attn_pv_step<1>(oacc, tra, pf[ks]); else attn_pv_step<0>(oacc, tra, pf[ks]);
            if (ks + 2 < 8) { if (ks & 1) ATTN_DMA(ks + 2, 1); else ATTN_DMA(ks + 2, 0); }
        }
#undef ATTN_DMA
        if (fr < 4) { bf16_t* yo = YA + (size_t)t * AW + (kvh * 4 + fr) * 128 + fq * 4;
#pragma unroll
            for (int c = 0; c < 8; ++c) { u32x2 w; w.x = cvt_pk_bf16(oacc[c][0] * inv, oacc[c][1] * inv); w.y = cvt_pk_bf16(oacc[c][2] * inv, oacc[c][3] * inv); *(u32x2*)(yo + c * 16) = w; } }
        LDS_WAIT(); asm volatile("" ::: "memory");
    }
}

#define AT_KSLOT(f) (((f) & 3) * 4096)
#define AT_FILL_K(SW, KH, tt) do { _Pragma("unroll") for (int j_ = 0; j_ < 4; ++j_) { const int r_ = 4 * j_ + fq; const int pos_ = 32 * ((tt) >> 1) + 8 * (r_ >> 2) + 4 * ((tt) & 1) + (r_ & 3); \
        const int key_ = (SW)[pos_]; const unsigned ch_ = (unsigned)fr ^ ((((unsigned)r_ & 3u) << 2) | (((unsigned)r_ >> 2) & 3u)); \
        __builtin_amdgcn_global_load_lds((const unsigned*)((KH) + (size_t)key_ * 256 + ch_ * 8), (LAS unsigned*)(wl + AT_KSLOT(tt) + j_ * 1024), 16, 0, 0); } } while (0)
#define AT_FILL_V(SW, VH, g) do { _Pragma("unroll") for (int j_ = 0; j_ < 4; ++j_) { const int row_ = 16 * ((g) & 1) + 4 * j_ + fq; const int key_ = (SW)[((g) >> 1) * 32 + row_]; \
        const unsigned ch_ = (unsigned)fr ^ ((((unsigned)row_ & 3u) << 2) | (((unsigned)row_ >> 2) & 3u)); \
        __builtin_amdgcn_global_load_lds((const unsigned*)((VH) + (size_t)key_ * 256 + ch_ * 8), (LAS unsigned*)(wl + AT_KSLOT(g) + j_ * 1024), 16, 0, 0); } } while (0)
#define AT_ISSUE(F) do { if ((F) < 16) AT_FILL_K(selc, Khc, (F)); else if ((F) < 32) AT_FILL_V(selc, Vhc, (F) - 16); else if (has_next) AT_FILL_K(seln, Khn, (F) - 32); } while (0)

__device__ __forceinline__ void phase_attn_stream(const Frame& F, int wb, int wG) {
    const bf16_t* Q = (const bf16_t*)(F.ws + WS_Q); const bf16_t* Kb = (const bf16_t*)(F.ws + WS_K); const bf16_t* Vb = (const bf16_t*)(F.ws + WS_V); const int* SEL = (const int*)(F.ws + WS_SEL);
    bf16_t* YA = (bf16_t*)(F.ws + WS_YA);
    const int lane = F.lane, fr = lane & 15, fq = lane >> 4;
    LAS unsigned char* wl = F.lds + F.wave * 16384;
    LAS int* selc = (LAS int*)(F.lds + LDS_AUX + F.wave * 2048);
    LAS int* seln = selc + 256;
    const unsigned wl_addr = (unsigned)(size_t)wl;
    unsigned tra[8][2];
    { const unsigned g = fq, q = (lane & 15) >> 2, p = lane & 3;
#pragma unroll
      for (int c = 0; c < 8; ++c)
#pragma unroll
          for (int t2 = 0; t2 < 2; ++t2) tra[c][t2] = wl_addr + off_b(8 * g + 4 * t2 + q, 2 * c + (p >> 1)) + 8 * (p & 1); }
    unsigned kra[4];
#pragma unroll
    for (int ks = 0; ks < 4; ++ks) kra[ks] = off_b((unsigned)fr, (unsigned)(4 * ks + fq));
    const float c2 = 0.08838834764831845f * 1.4426950408889634f;
    const int stride = wG * NWAVES, ntask = T * NKV;
    int task = wb * NWAVES + F.wave;
    if (task >= ntask) return;
    int t = task >> 1, kvh = task & 1; int nsel = (t + 1) < TOPK ? (t + 1) : TOPK;
#pragma unroll
    for (int i = 0; i < 4; ++i) { const int pos = i * 64 + lane; selc[pos] = (pos < nsel) ? SEL[(size_t)t * TOPK + pos] : 0; }
    bf16x8 qf[4];
#pragma unroll
    for (int ks = 0; ks < 4; ++ks) { qf[ks] = (bf16x8){0, 0, 0, 0, 0, 0, 0, 0}; if (fr < 4) qf[ks] = *(const bf16x8*)(Q + (size_t)t * AW + (kvh * 4 + fr) * 128 + ks * 32 + fq * 8); }
    LDS_WAIT(); asm volatile("" ::: "memory");
    asm volatile("" : "+v"(qf[0]), "+v"(qf[1]), "+v"(qf[2]), "+v"(qf[3]));
    const bf16_t* Khc = Kb + kvh * 128; const bf16_t* Vhc = Vb + kvh * 128;
    { const bool has_next = false; const bf16_t* Khn = Khc; AT_ISSUE(0); AT_ISSUE(1); AT_ISSUE(2); AT_ISSUE(3); (void)has_next; (void)Khn; }
#pragma unroll 1
    for (;;) {
        const int ntk = task + stride; const bool has_next = ntk < ntask;
        const int tn = has_next ? (ntk >> 1) : t, kvhn = has_next ? (ntk & 1) : kvh; const int nseln = (tn + 1) < TOPK ? (tn + 1) : TOPK;
        const bf16_t* Khn = Kb + kvhn * 128; const bf16_t* Vhn = Vb + kvhn * 128;
        int sn[4]; bf16x8 qn[4];
#pragma unroll
        for (int i = 0; i < 4; ++i) { const int pos = i * 64 + lane; sn[i] = (has_next && pos < nseln) ? SEL[(size_t)tn * TOPK + pos] : 0; }
#pragma unroll
        for (int ks = 0; ks < 4; ++ks) { qn[ks] = (bf16x8){0, 0, 0, 0, 0, 0, 0, 0}; if (has_next && fr < 4) qn[ks] = *(const bf16x8*)(Q + (size_t)tn * AW + (kvhn * 4 + fr) * 128 + ks * 32 + fq * 8); }
        f32x4 sacc[16];
#pragma unroll
        for (int tt = 0; tt < 16; ++tt) {
            asm volatile("s_waitcnt vmcnt(12)" ::: "memory");
            const LAS unsigned char* kb = wl + AT_KSLOT(tt);
            const bf16x8 k0 = *(const LAS bf16x8*)(kb + kra[0]), k1 = *(const LAS bf16x8*)(kb + kra[1]), k2 = *(const LAS bf16x8*)(kb + kra[2]), k3 = *(const LAS bf16x8*)(kb + kra[3]);
            LDS_WAIT(); asm volatile("" ::: "memory");
            AT_ISSUE(tt + 4);
            f32x4 d = (f32x4){0.f, 0.f, 0.f, 0.f};
            d = __builtin_amdgcn_mfma_f32_16x16x32_bf16(k0, qf[0], d, 0, 0, 0);
            d = __builtin_amdgcn_mfma_f32_16x16x32_bf16(k1, qf[1], d, 0, 0, 0);
            d = __builtin_amdgcn_mfma_f32_16x16x32_bf16(k2, qf[2], d, 0, 0, 0);
            d = __builtin_amdgcn_mfma_f32_16x16x32_bf16(k3, qf[3], d, 0, 0, 0);
            sacc[tt] = d;
        }
#pragma unroll
        for (int i = 0; i < 4; ++i) seln[i * 64 + lane] = sn[i];
        asm volatile("" : "+v"(qn[0]), "+v"(qn[1]), "+v"(qn[2]), "+v"(qn[3]));
        float m = -__builtin_inff();
#pragma unroll
        for (int tt = 0; tt < 16; ++tt)
#pragma unroll
            for (int j = 0; j < 4; ++j) { const int pos = 32 * (tt >> 1) + 8 * fq + 4 * (tt & 1) + j; const float v = (pos < nsel) ? sacc[tt][j] : -__builtin_inff(); sacc[tt][j] = v; m = fmaxf(m, v); }
        m = fmaxf(m, __shfl_xor(m, 16)); m = fmaxf(m, __shfl_xor(m, 32));
        float sum = 0.f; const float mc = m * c2;
#pragma unroll
        for (int tt = 0; tt < 16; ++tt)
#pragma unroll
            for (int j = 0; j < 4; ++j) { const float p = __builtin_amdgcn_exp2f(sacc[tt][j] * c2 - mc); sacc[tt][j] = p; sum += p; }
        sum += __shfl_xor(sum, 16); sum += __shfl_xor(sum, 32);
        const float inv = 1.0f / sum;
        bf16x8 pf[8];
#pragma unroll
        for (int ks = 0; ks < 8; ++ks) { u32x4 w; w.x = cvt_pk_bf16(sacc[2 * ks][0], sacc[2 * ks][1]); w.y = cvt_pk_bf16(sacc[2 * ks][2], sacc[2 * ks][3]);
            w.z = cvt_pk_bf16(sacc[2 * ks + 1][0], sacc[2 * ks + 1][1]); w.w = cvt_pk_bf16(sacc[2 * ks + 1][2], sacc[2 * ks + 1][3]); pf[ks] = __builtin_bit_cast(bf16x8, w); }
        f32x4 oacc[8];
#pragma unroll
        for (int c = 0; c < 8; ++c) oacc[c] = (f32x4){0.f, 0.f, 0.f, 0.f};
        LDS_WAIT(); asm volatile("" ::: "memory");
#pragma unroll
        for (int ks = 0; ks < 8; ++ks) {
            if (ks < 7 || has_next) asm volatile("s_waitcnt vmcnt(8)" ::: "memory"); else asm volatile("s_waitcnt vmcnt(0)" ::: "memory");
            if (ks & 1) attn_pv_step<1>(oacc, tra, pf[ks]); else attn_pv_step<0>(oacc, tra, pf[ks]);
            AT_ISSUE(20 + 2 * ks); AT_ISSUE(21 + 2 * ks);
        }
        if (fr < 4) { bf16_t* yo = YA + (size_t)t * AW + (kvh * 4 + fr) * 128 + fq * 4;
#pragma unroll
            for (int c = 0; c < 8; ++c) { u32x2 w; w.x = cvt_pk_bf16(oacc[c][0] * inv, oacc[c][1] * inv); w.y = cvt_pk_bf16(oacc[c][2] * inv, oacc[c][3] * inv); *(u32x2*)(yo + c * 16) = w; } }
        if (!has_next) break;
        task = ntk; t = tn; kvh = kvhn; nsel = nseln; Khc = Khn; Vhc = Vhn;
#pragma unroll
        for (int ks = 0; ks < 4; ++ks) qf[ks] = qn[ks];
        { LAS int* tmp = selc; selc = seln; seln = tmp; }
    }
    asm volatile("s_waitcnt vmcnt(0)" ::: "memory");
}
#undef AT_ISSUE
#undef AT_FILL_K
#undef AT_FILL_V
#undef AT_KSLOT

__device__ __forceinline__ void phase_ln1_route(const Frame& F, const float* g1, const float* b1, const float* rbias) {
    const bf16_t* PRE = (const bf16_t*)(F.ws + WS_PRE1); bf16_t* H1B = (bf16_t*)(F.ws + WS_H1B); unsigned char* H18 = F.ws + WS_H18;
    const bf16_t* RH = (const bf16_t*)(F.ws + WS_RT); const bf16_t* RL = RH + (size_t)NE * D;
    unsigned* cnt = (unsigned*)(F.ws + WS_CTL) + CW_CNT; int* TOKL = (int*)(F.ws + WS_TOKL); int* SLOT = (int*)(F.ws + WS_SLOT); float* GATE = (float*)(F.ws + WS_GATE);
    LAS bf16_t* hh = (LAS bf16_t*)F.lds;
    LAS bf16_t* hl = (LAS bf16_t*)(F.lds + 16 * 2056 * 2);
    LAS float* lg = (LAS float*)(F.lds + 2 * 16 * 2056 * 2);
    LAS float* gbuf = lg + 16 * 64;
    LAS unsigned long long* smask = (LAS unsigned long long*)(gbuf + 16 * 64);
    const int lane = F.lane, wave = F.wave, fr = lane & 15, fq = lane >> 4;
    const float bias_l = rbias[lane];
    for (int task = blockIdx.x; task < T / 16; task += F.G) {
        const int r0 = task * 16;
        int zero_; asm volatile("s_mov_b32 %0, 0" : "=s"(zero_));
        const float* g1t = g1 + zero_; const float* b1t = b1 + zero_; const bf16_t* RHt = RH + zero_; const bf16_t* RLt = RL + zero_;
        for (int i = F.tid; i < 16 * 64; i += NTHR) lg[i] = 0.f;
        {
            f32x4 v[2][8]; float s[2] = {0.f, 0.f};
#pragma unroll
            for (int rr = 0; rr < 2; ++rr) { const u32x2* xr = (const u32x2*)(PRE + (size_t)(r0 + wave * 2 + rr) * D) + lane;
#pragma unroll
                for (int j = 0; j < 8; ++j) { const u32x2 w = xr[64 * j]; v[rr][j] = (f32x4){bflo(w.x), bfhi(w.x), bflo(w.y), bfhi(w.y)}; } }
#pragma unroll
            for (int rr = 0; rr < 2; ++rr)
#pragma unroll
                for (int j = 0; j < 8; ++j) s[rr] += (v[rr][j][0] + v[rr][j][1]) + (v[rr][j][2] + v[rr][j][3]);
#pragma unroll
            for (int rr = 0; rr < 2; ++rr) {
                const int lr = wave * 2 + rr; const size_t row = (size_t)(r0 + lr);
                const float mean = wave_sum(s[rr]) * (1.f / D); float s2 = 0.f;
#pragma unroll
                for (int j = 0; j < 8; ++j) { v[rr][j] = v[rr][j] - mean; s2 += (v[rr][j][0] * v[rr][j][0] + v[rr][j][1] * v[rr][j][1]) + (v[rr][j][2] * v[rr][j][2] + v[rr][j][3] * v[rr][j][3]); }
                const float rstd = 1.0f / sqrtf(wave_sum(s2) * (1.f / D) + LN_EPS);
#pragma unroll
                for (int j = 0; j < 8; ++j) { const int c = 4 * lane + 256 * j; const f32x4 gg = *(const f32x4*)(g1t + c), bb = *(const f32x4*)(b1t + c);
                    f32x4 y; unsigned hi[4]; float lo[4];
#pragma unroll
                    for (int e = 0; e < 4; ++e) { y[e] = v[rr][j][e] * rstd * gg[e] + bb[e]; hi[e] = f2bf(y[e]); lo[e] = y[e] - bf2f(hi[e]); }
                    u32x2 wh; wh.x = hi[0] | (hi[1] << 16); wh.y = hi[2] | (hi[3] << 16);
                    *(u32x2*)(H1B + row * D + c) = wh;
                    *(unsigned*)(H18 + row * D + c) = pk4_fp8(y[0], y[1], y[2], y[3]);
                    *(LAS u32x2*)(hh + lr * 2056 + c) = wh;
                    u32x2 wl; wl.x = cvt_pk_bf16(lo[0], lo[1]); wl.y = cvt_pk_bf16(lo[2], lo[3]);
                    *(LAS u32x2*)(hl + lr * 2056 + c) = wl; }
            }
        }
        __syncthreads();
        {
            f32x4 dacc[4];
#pragma unroll
            for (int et = 0; et < 4; ++et) dacc[et] = (f32x4){0.f, 0.f, 0.f, 0.f};
#pragma unroll
            for (int kh = 0; kh < 4; ++kh) {
                bf16x8 bh[2][4], bl[2][4];
#pragma unroll
                for (int k4 = 0; k4 < 2; ++k4)
#pragma unroll
                    for (int et = 0; et < 4; ++et) { const int k0 = wave * 256 + (kh * 2 + k4) * 32 + fq * 8;
                        bh[k4][et] = *(const bf16x8*)(RHt + (size_t)(et * 16 + fr) * D + k0); bl[k4][et] = *(const bf16x8*)(RLt + (size_t)(et * 16 + fr) * D + k0); }
#pragma unroll
                for (int k4 = 0; k4 < 2; ++k4) { const int k0 = wave * 256 + (kh * 2 + k4) * 32 + fq * 8;
                    const bf16x8 ah = *(const LAS bf16x8*)(hh + fr * 2056 + k0), al = *(const LAS bf16x8*)(hl + fr * 2056 + k0);
#pragma unroll
                    for (int et = 0; et < 4; ++et) {
                        dacc[et] = __builtin_amdgcn_mfma_f32_16x16x32_bf16(ah, bh[k4][et], dacc[et], 0, 0, 0);
                        dacc[et] = __builtin_amdgcn_mfma_f32_16x16x32_bf16(ah, bl[k4][et], dacc[et], 0, 0, 0);
                        dacc[et] = __builtin_amdgcn_mfma_f32_16x16x32_bf16(al, bh[k4][et], dacc[et], 0, 0, 0); } }
            }
#pragma unroll
            for (int et = 0; et < 4; ++et)
#pragma unroll
                for (int j = 0; j < 4; ++j) lds_addf(&lg[(fq * 4 + j) * 64 + et * 16 + fr], dacc[et][j]);
        }
        __syncthreads();
#pragma unroll 1
        for (int rr = 0; rr < 2; ++rr) {
            const int lr = wave * 2 + rr;
            const float score = fast_sigmoid(lg[lr * 64 + lane]); const float biased = score + bias_l;
            int rk = 0;
#pragma unroll
            for (int o = 1; o < 8; ++o) { const int src = (lane & ~7) | ((lane + o) & 7); const float ov = __shfl(biased, src); rk += (ov > biased || (ov == biased && src < lane)) ? 1 : 0; }
            float g2 = rk < 2 ? biased : 0.f;
            g2 += __shfl_xor(g2, 1); g2 += __shfl_xor(g2, 2); g2 += __shfl_xor(g2, 4);
            int grk = 0; const int mygrp = lane >> 3;
#pragma unroll
            for (int gg = 0; gg < 8; ++gg) { const float ov = u2f((unsigned)__builtin_amdgcn_readlane((int)f2u(g2), gg * 8));
                grk += (gg != mygrp && (ov > g2 || (ov == g2 && gg < mygrp))) ? 1 : 0; }
            const float cand = grk < 4 ? biased : -__builtin_inff();
            int erk = 0;
#pragma unroll
            for (int e = 0; e < 64; ++e) { const float ov = u2f((unsigned)__builtin_amdgcn_readlane((int)f2u(cand), e)); erk += (e != lane && (ov > cand || (ov == cand && e < lane))) ? 1 : 0; }
            const bool selq = erk < 8;
            const float gsum = wave_sum(selq ? score : 0.f);
            gbuf[lr * 64 + lane] = score / gsum * 2.5f;
            const unsigned long long m = __ballot(selq);
            if (lane == 0) smask[lr] = m;
        }
        __syncthreads();
        if (wave == 0) {
            int n = 0;
#pragma unroll
            for (int tk = 0; tk < 16; ++tk) n += (int)((smask[tk] >> lane) & 1ull);
            unsigned pos = 0; if (n) pos = atomicAdd(&cnt[lane], (unsigned)n);
#pragma unroll
            for (int tk = 0; tk < 16; ++tk) { const unsigned long long m = smask[tk];
                if ((m >> lane) & 1ull) { const int tok = r0 + tk; const int k = __builtin_popcountll(m & ((1ull << lane) - 1ull));
                    TOKL[lane * T + pos] = tok; SLOT[tok * 8 + k] = (lane << 16) | (int)pos; GATE[tok * 8 + k] = gbuf[tk * 64 + lane]; ++pos; } }
        }
        __syncthreads();
    }
}

__device__ __forceinline__ void phase_ln2(const Frame& F, const float* g2, const float* b2, float* out) {
    const bf16_t* ACC2 = (const bf16_t*)(F.ws + WS_ACC2); const unsigned char* Y = F.ws + WS_Y; const int* SLOT = (const int*)(F.ws + WS_SLOT); const float* GATE = (const float*)(F.ws + WS_GATE);
    const unsigned* cnt = (const unsigned*)(F.ws + WS_CTL) + CW_CNT;
    LAS int* tstart = (LAS int*)(F.lds + LDS_AUX);
    if (F.tid == 0) { int acc = 0; for (int e = 0; e < NE; ++e) { tstart[e] = acc; acc += ((int)cnt[e] + 255) >> 8; } tstart[NE] = acc; tstart[NE + 1] = acc + T / 256; }
    __syncthreads();
    const int lane = F.lane;
    for (int row = F.gw; row < T; row += F.NGW) {
        f32x4 v[8];
        const u32x2* xr = (const u32x2*)(ACC2 + (size_t)row * D) + lane;
#pragma unroll
        for (int j = 0; j < 8; ++j) { const u32x2 w = xr[64 * j]; v[j] = (f32x4){bflo(w.x), bfhi(w.x), bflo(w.y), bfhi(w.y)}; }
        int si[8]; float gt[8];
        { const u32x4 s0 = *(const u32x4*)(SLOT + row * 8), s1 = *(const u32x4*)(SLOT + row * 8 + 4); const f32x4 g0 = *(const f32x4*)(GATE + row * 8), g1 = *(const f32x4*)(GATE + row * 8 + 4);
          si[0] = (int)s0.x; si[1] = (int)s0.y; si[2] = (int)s0.z; si[3] = (int)s0.w; si[4] = (int)s1.x; si[5] = (int)s1.y; si[6] = (int)s1.z; si[7] = (int)s1.w;
          gt[0] = g0[0]; gt[1] = g0[1]; gt[2] = g0[2]; gt[3] = g0[3]; gt[4] = g1[0]; gt[5] = g1[1]; gt[6] = g1[2]; gt[7] = g1[3]; }
#pragma unroll
        for (int kb = 0; kb < 3; ++kb) {
            unsigned w[3][8]; float g[3];
#pragma unroll
            for (int u = 0; u < 3; ++u) { const int k = kb * 3 + u; size_t yrow;
                if (k < 8) { yrow = (size_t)tstart[si[k] >> 16] * 256 + (si[k] & 0xffff); g[u] = gt[k] * Y8_INV; } else { yrow = (size_t)tstart[NE] * 256 + row; g[u] = Y8_INV; }
                const unsigned* yr = (const unsigned*)(Y + yrow * D) + lane;
#pragma unroll
                for (int j = 0; j < 8; ++j) w[u][j] = yr[64 * j]; }
#pragma unroll
            for (int u = 0; u < 3; ++u)
#pragma unroll
                for (int j = 0; j < 8; ++j) { const f32x2 lo = __builtin_amdgcn_cvt_pk_f32_fp8((int)w[u][j], false), hi = __builtin_amdgcn_cvt_pk_f32_fp8((int)w[u][j], true);
                    v[j][0] += g[u] * lo[0]; v[j][1] += g[u] * lo[1]; v[j][2] += g[u] * hi[0]; v[j][3] += g[u] * hi[1]; }
        }
        float s = 0.f;
#pragma unroll
        for (int j = 0; j < 8; ++j) s += (v[j][0] + v[j][1]) + (v[j][2] + v[j][3]);
        const float mean = wave_sum(s) * (1.f / D); float s2 = 0.f;
#pragma unroll
        for (int j = 0; j < 8; ++j) { v[j] = v[j] - mean; s2 += (v[j][0] * v[j][0] + v[j][1] * v[j][1]) + (v[j][2] * v[j][2] + v[j][3] * v[j][3]); }
        const float rstd = 1.0f / sqrtf(wave_sum(s2) * (1.f / D) + LN_EPS);
#pragma unroll
        for (int j = 0; j < 8; ++j) { const int c = 4 * lane + 256 * j; const f32x4 gg = *(const f32x4*)(g2 + c), bb = *(const f32x4*)(b2 + c);
            f32x4 y;
#pragma unroll
            for (int e = 0; e < 4; ++e) y[e] = v[j][e] * rstd * gg[e] + bb[e];
            *(f32x4*)(out + (size_t)row * D + c) = y; }
    }
}

constexpr int N_PHASES = 10;
__global__ void __launch_bounds__(NTHR, 2) fwd(Args args) {
    extern __shared__ __attribute__((aligned(16))) unsigned char lds_raw[];
    Frame F;
    F.lds = (LAS unsigned char*)lds_raw; F.tid = threadIdx.x; F.lane = F.tid & 63; F.wave = __builtin_amdgcn_readfirstlane(F.tid >> 6);
    F.G = gridDim.x; { const int bx = blockIdx.x; F.vcu = (F.G % 8 == 0) ? (bx % 8) * (F.G / 8) + bx / 8 : bx; }
    F.gw = blockIdx.x * NWAVES + F.wave; F.NGW = F.G * NWAVES; F.ws = args.ws;
    unsigned char* ws = args.ws;
    volatile LAS unsigned* MISC = (volatile LAS unsigned*)(F.lds + LDS_MISC);
    if (F.tid < 64) MISC[F.tid] = 0u;
    __syncthreads();
#if MK_N_LAUNCHES == 1
    XcdBarrier bar = xcd_barrier_post((unsigned*)(ws + WS_CTL) + CW_BAR, MISC + 8);
#define GRID_BAR() xcd_barrier(bar)
#else
#define GRID_BAR() do {} while (0)
#endif
    const int lo = args.ph_lo, hi = args.ph_hi;
#ifndef PHASE_MASK
#define PHASE_MASK 0x3ff
#endif
#define IN(k) (((PHASE_MASK >> (k)) & 1) && lo <= (k) && (k) < hi)
#define SEAM(k) do { if (IN(k) && IN((k) + 1)) GRID_BAR(); } while (0)

#ifndef PROBE_DOUBLE
#define PROBE_DOUBLE -1
#endif
#define PHASE(k, ...) do { if (IN(k)) { __VA_ARGS__ if (PROBE_DOUBLE == (k)) { GRID_BAR(); __VA_ARGS__ } SEAM(k); } } while (0)
    PHASE(0, { phase_convert(F, args); });
    PHASE(1, {
        { pg8::DenseSched S; S.init(ws + WS_XB, ws + WS_WIN, T, NIN_PAD, D, F.G, (int)blockIdx.x); EpiInProj E{ws}; pg8::gemm_phase(F.lds, S, E); }
        { pg8::DenseSched S; S.init(ws + WS_PB, ws + WS_WPE, T, D, PLE, F.G, (int)blockIdx.x); EpiPlain E{(bf16_t*)(ws + WS_PP), D}; pg8::gemm_phase(F.lds, S, E); }
    });
    const int wG = (int)F.G > 2 * NCONV ? (int)F.G - NCONV : (int)F.G; const bool is_conv = (int)blockIdx.x >= wG; const int ncw = ((int)F.G - wG) * NWAVES, cw = ((int)blockIdx.x - wG) * NWAVES + F.wave;
    PHASE(2, { if (is_conv) convert_range(args, ws, CV_P0_END, CV_SPLIT, cw, ncw, F.lane);
               else { phase_yconv(F, karg(3), (int)blockIdx.x, wG); phase_indexer(F, (int)blockIdx.x, wG); }
               if (wG == (int)F.G) convert_range(args, ws, CV_P0_END, CV_SPLIT, F.gw, F.NGW, F.lane); });
    PHASE(3, {
        { pg8::DenseSched S; S.init(ws + WS_YC, ws + WS_WB, T, D, CW, F.G, (int)blockIdx.x); EpiGate<false> E{(const bf16_t*)(ws + WS_SB), nullptr, (bf16_t*)(ws + WS_M1)}; pg8::gemm_phase(F.lds, S, E); }
        if (is_conv) convert_range(args, ws, CV_SPLIT, CV_N7, cw, ncw, F.lane);
#ifdef ATTN_V1
        else phase_attn_mfma(F, (int)blockIdx.x, wG);
#else
        else phase_attn_stream(F, (int)blockIdx.x, wG);
#endif
        if (wG == (int)F.G) convert_range(args, ws, CV_SPLIT, CV_N7, F.gw, F.NGW, F.lane);
    });
    PHASE(4, {
        pg8::DenseSched S; S.init(ws + WS_YA, ws + WS_WA, T, D, AW, F.G, (int)blockIdx.x); EpiGate<true> E{(const bf16_t*)(ws + WS_SA), (const bf16_t*)(ws + WS_M1), (bf16_t*)(ws + WS_MG)}; pg8::gemm_phase(F.lds, S, E);
    });
    PHASE(5, {
        pg8::DenseSched S; S.init(ws + WS_MG, ws + WS_WO, T, D, D, F.G, (int)blockIdx.x); EpiResid E{karg(0), (bf16_t*)(ws + WS_PRE1)}; pg8::gemm_phase(F.lds, S, E);
    });
#ifdef PROBE_DOUBLE_P6
    if (IN(6)) { phase_ln1_route(F, karg(7), karg(8), karg(10)); GRID_BAR();
        if (blockIdx.x == 0 && F.tid < NE) ((unsigned*)(ws + WS_CTL) + CW_CNT)[F.tid] = 0u;
        GRID_BAR(); }
#endif
    PHASE(6, { phase_ln1_route(F, karg(7), karg(8), karg(10)); });
    PHASE(7, {
        LAS int* tstart = (LAS int*)(F.lds + LDS_AUX);
        const unsigned* cnt = (const unsigned*)(ws + WS_CTL) + CW_CNT;
        if (F.tid == 0) { int acc = 0; for (int e = 0; e < NE; ++e) { tstart[e] = acc; acc += ((int)cnt[e] + 255) >> 8; } tstart[NE] = acc; tstart[NE + 1] = acc + T / 256; }
        __syncthreads();
        { pg8::MoeSched<true> S; S.A = (const char*)(ws + WS_H18); S.Bt = (const char*)(ws + WS_W1); S.bstride = (size_t)1024 * D; S.K = D; S.rowb = D; S.npn = 4; S.tstart = tstart; S.cnt = (const int*)cnt; S.tokl = (const int*)(ws + WS_TOKL);
          S.total = __builtin_amdgcn_readfirstlane(tstart[NE + 1]) * 4; S.G = F.G; S.c = F.vcu; EpiSwiGlu E{ws + WS_HID}; pg8::gemm_phase<EpiSwiGlu, pg8::MoeSched<true>, true>(F.lds, S, E); }
        { pg8::DenseSched S; S.init(ws + WS_H1B, ws + WS_WPG, T, D, D, F.G, (int)blockIdx.x); EpiPle E{(const bf16_t*)(ws + WS_H1B), (const bf16_t*)(ws + WS_PP), (bf16_t*)(ws + WS_ACC2)}; pg8::gemm_phase(F.lds, S, E); }
    });
    PHASE(8, {
        LAS int* tstart = (LAS int*)(F.lds + LDS_AUX);
        const unsigned* cnt = (const unsigned*)(ws + WS_CTL) + CW_CNT;
        if (F.tid == 0) { int acc = 0; for (int e = 0; e < NE; ++e) { tstart[e] = acc; acc += ((int)cnt[e] + 255) >> 8; } tstart[NE] = acc; tstart[NE + 1] = acc + T / 256; }
        __syncthreads();
        pg8::MoeSched<false> S; S.A = (const char*)(ws + WS_HID); S.Bt = (const char*)(ws + WS_W2); S.bstride = (size_t)D * EFF; S.K = EFF; S.rowb = EFF; S.npn = 8; S.tstart = tstart; S.cnt = (const int*)cnt; S.tokl = nullptr;
        S.total = __builtin_amdgcn_readfirstlane(tstart[NE + 1]) * 8; S.G = F.G; S.c = F.vcu; EpiY8 E{ws + WS_Y, Y8_SCALE * W8_INV}; pg8::gemm_phase<EpiY8, pg8::MoeSched<false>, true>(F.lds, S, E);
    });
    PHASE(9, { phase_ln2(F, karg(19), karg(20), (float*)karg(21)); });
}

extern "C" void kernel_launch(void* const* d_in, const int* in_sizes, int n_in, void* d_out, int out_size, void* d_ws, size_t ws_size, hipStream_t stream) {
    static int grid = 0;
    if (!grid) {
        if (n_in != 21 || ws_size < WS_END) { fprintf(stderr, "kernel_launch: unexpected n_in %d / ws_size %zu (need %zu)\n", n_in, ws_size, (size_t)WS_END); grid = -1; return; }
        int dev = 0, cus = 0, per_cu = 0;
        hipGetDevice(&dev); hipDeviceGetAttribute(&cus, hipDeviceAttributeMultiprocessorCount, dev);
        if (hipFuncSetAttribute((const void*)fwd, hipFuncAttributeMaxDynamicSharedMemorySize, LDS_BYTES) != hipSuccess) { fprintf(stderr, "kernel_launch: hipFuncSetAttribute failed\n"); grid = -1; return; }
        hipOccupancyMaxActiveBlocksPerMultiprocessor(&per_cu, (const void*)fwd, NTHR, LDS_BYTES);
        if (per_cu < 1) fprintf(stderr, "kernel_launch: occupancy query says %d\n", per_cu);
        grid = cus;
    }
    if (grid <= 0) return;
    hipMemsetAsync((char*)d_ws + WS_CTL, 0, CTL_BYTES, stream);
    Args a{};
    for (int i = 0; i < 21; ++i) a.in[i] = (const float*)d_in[i];
    a.out = (float*)d_out; a.ws = (unsigned char*)d_ws;
#if MK_N_LAUNCHES == 1
    a.ph_lo = 0; a.ph_hi = N_PHASES;
    hipLaunchKernelGGL(fwd, dim3(grid), dim3(NTHR), LDS_BYTES, stream, a);
#else
    for (int p = 0; p < N_PHASES; ++p) { a.ph_lo = p; a.ph_hi = p + 1; hipLaunchKernelGGL(fwd, dim3(grid), dim3(NTHR), LDS_BYTES, stream, a); }
#endif
}
```

```cpp
#include <hip/hip_runtime.h>
#include <cstdio>
#include <cstdint>

#ifndef MK_N_LAUNCHES
#define MK_N_LAUNCHES 1
#endif

#define GAS __attribute__((address_space(1)))
#define LAS __attribute__((address_space(3)))
typedef unsigned short bf16_t;
typedef short bf16x8 __attribute__((ext_vector_type(8)));
typedef float f32x4 __attribute__((ext_vector_type(4)));
typedef float f32x2 __attribute__((ext_vector_type(2)));
typedef unsigned u32x4 __attribute__((ext_vector_type(4)));
typedef unsigned u32x2 __attribute__((ext_vector_type(2)));
typedef long l64x2 __attribute__((ext_vector_type(2)));
typedef int i32x4 __attribute__((ext_vector_type(4)));
typedef int i32x8 __attribute__((ext_vector_type(8)));

constexpr int T = 8192, D = 2048;
constexpr int NH = 8, NKV = 2, HD = 128, AW = 1024;
constexpr int IH = 16, IDIM = 64, TOPK = 256;
constexpr int CW = 1024;
constexpr int NE = 64, EFF = 512, PLE = 256;
constexpr int IN_W = 9808;
constexpr int NIN_PAD = 9984;
constexpr float LN_EPS = 1e-5f;
constexpr float ALPHA = 1.189207115002721f;
constexpr int NWAVES = 8, NTHR = 512;

constexpr size_t MiB = 1u << 20;
constexpr size_t WS_CTL = 0, CTL_BYTES = 1 * MiB;
constexpr size_t WS_WIN = 1 * MiB;
constexpr size_t WS_WA = WS_WIN + 39 * MiB;
constexpr size_t WS_WB = WS_WA + 4 * MiB;
constexpr size_t WS_WO = WS_WB + 4 * MiB;
constexpr size_t WS_WPG = WS_WO + 8 * MiB;
constexpr size_t WS_WPE = WS_WPG + 8 * MiB;
constexpr size_t WS_RT = WS_WPE + 1 * MiB;
constexpr size_t WS_XB = WS_RT + 1 * MiB;
constexpr size_t WS_W1 = WS_XB + 32 * MiB;
constexpr size_t WS_Y = 1 * MiB;
constexpr size_t WS_W2 = WS_W1 + 260 * MiB;
static_assert(WS_Y + (size_t)90112 * 2048 * 2 <= WS_W2, "Y overlay");
constexpr size_t WS_Q = WS_W2 + 130 * MiB;
constexpr size_t WS_K = WS_Q + 16 * MiB;
constexpr size_t WS_V = WS_K + 4 * MiB;
constexpr size_t WS_QI = WS_V + 4 * MiB;
constexpr size_t WS_MISC = WS_QI + 16 * MiB;
constexpr size_t WS_WI = WS_MISC + 4 * MiB;
constexpr size_t WS_CB = WS_WI + 1 * MiB;
constexpr size_t WS_CC = WS_CB + 16 * MiB;
constexpr size_t WS_CH = WS_CC + 16 * MiB;
constexpr size_t WS_SA = WS_CH + 16 * MiB;
constexpr size_t WS_SB = WS_SA + 32 * MiB;
constexpr size_t WS_M1 = WS_SB + 32 * MiB;
constexpr size_t WS_H18 = WS_Q;
constexpr size_t WS_HID = WS_SA;
constexpr size_t WS_MG = WS_M1 + 32 * MiB;
constexpr size_t WS_PP = WS_MG + 32 * MiB;
constexpr size_t WS_PB = WS_PP + 32 * MiB;
constexpr size_t WS_YC = WS_PB + 4 * MiB;
constexpr size_t WS_SEL = WS_YC + 16 * MiB;
constexpr size_t WS_YA = WS_SEL + 8 * MiB;
constexpr size_t WS_PRE1 = WS_YA + 16 * MiB;
constexpr size_t WS_ACC2 = WS_PRE1;
constexpr size_t WS_H1F = WS_PRE1 + 64 * MiB;
constexpr size_t WS_H1B = WS_H1F + 64 * MiB;
constexpr size_t WS_TOKL = WS_H1B + 32 * MiB;
constexpr size_t WS_SLOT = WS_TOKL + 2 * MiB;
constexpr size_t WS_GATE = WS_SLOT + 1 * MiB;
constexpr size_t WS_END = WS_GATE + 1 * MiB;
static_assert(WS_END <= 1000 * MiB, "workspace map");

constexpr int CW_CNT = 64;
constexpr int CW_BAR = 4096;

constexpr int RING_BYTES = 131072;
constexpr int LDS_AUX = RING_BYTES;
constexpr int AUX_BYTES = 16384 + 1024;
constexpr int LDS_MISC = LDS_AUX + AUX_BYTES;
constexpr int LDS_BYTES = LDS_MISC + 256;

__device__ __forceinline__ unsigned f2bf(float f) { unsigned u = __builtin_bit_cast(unsigned, f); return (u + 0x7fffu + ((u >> 16) & 1u)) >> 16; }
__device__ __forceinline__ float bf2f(unsigned b) { return __builtin_bit_cast(float, b << 16); }
__device__ __forceinline__ float u2f(unsigned u) { return __builtin_bit_cast(float, u); }
__device__ __forceinline__ unsigned f2u(float f) { return __builtin_bit_cast(unsigned, f); }
__device__ __forceinline__ float bflo(unsigned w) { return __builtin_bit_cast(float, w << 16); }
__device__ __forceinline__ float bfhi(unsigned w) { return __builtin_bit_cast(float, w & 0xffff0000u); }
__device__ __forceinline__ unsigned cvt_pk_bf16(float lo, float hi) { unsigned r; asm volatile("v_cvt_pk_bf16_f32 %0, %1, %2" : "=v"(r) : "v"(lo), "v"(hi)); return r; }
__device__ __forceinline__ unsigned pk4_fp8(float a, float b, float c, float d) {
    int r = __builtin_amdgcn_cvt_pk_fp8_f32(a, b, 0, false); r = __builtin_amdgcn_cvt_pk_fp8_f32(c, d, r, true); return (unsigned)r; }
constexpr float W8_SCALE = 64.0f, W8_INV = 1.0f / 64.0f, Y8_SCALE = 16.0f, Y8_INV = 1.0f / 16.0f;
__device__ __forceinline__ float fast_sigmoid(float x) { return __builtin_amdgcn_rcpf(1.0f + __builtin_amdgcn_exp2f(-1.4426950408889634f * x)); }
#define LDS_WAIT() asm volatile("s_waitcnt lgkmcnt(0)" ::: "memory")
__device__ __forceinline__ unsigned lds_add(LAS unsigned* p, unsigned v) { return __hip_atomic_fetch_add(p, v, __ATOMIC_RELAXED, __HIP_MEMORY_SCOPE_WORKGROUP); }
__device__ __forceinline__ void lds_min(LAS unsigned* p, unsigned v) { (void)__hip_atomic_fetch_min(p, v, __ATOMIC_RELAXED, __HIP_MEMORY_SCOPE_WORKGROUP); }
__device__ __forceinline__ void lds_max(LAS unsigned* p, unsigned v) { (void)__hip_atomic_fetch_max(p, v, __ATOMIC_RELAXED, __HIP_MEMORY_SCOPE_WORKGROUP); }
__device__ __forceinline__ void lds_addf(LAS float* p, float v) { (void)__hip_atomic_fetch_add(p, v, __ATOMIC_RELAXED, __HIP_MEMORY_SCOPE_WORKGROUP); }
#define VM_WAIT() asm volatile("s_waitcnt vmcnt(0)" ::: "memory")

#define XB_TMO      128
#define XB_XCNT(j)  (256  + 64 * (j))
#define XB_XSUB(j)  (1280 + 64 * (j))
#define XB_XGEN(j)  (2304 + 64 * (j))
#define XB_TOP      3328
#define XB_TOPGEN   3392
#define XCD_BAR_WORDS 3456
#define XB_SPIN_CAP (1u << 18)
__device__ __forceinline__ unsigned xb_ld(unsigned* p)              { return __hip_atomic_load(p, __ATOMIC_RELAXED, __HIP_MEMORY_SCOPE_AGENT); }
__device__ __forceinline__ unsigned xb_add(unsigned* p, unsigned v) { return __hip_atomic_fetch_add(p, v, __ATOMIC_RELAXED, __HIP_MEMORY_SCOPE_AGENT); }
__device__ __forceinline__ unsigned xb_xcc_id() { return (unsigned)__builtin_amdgcn_s_getreg((3 << 11) | 20) & 0xFu; }
#define XB_SPIN(cond, bar) do { unsigned _sp = 0; while (cond) { __builtin_amdgcn_s_sleep(1); \
    if ((++_sp & 255u) == 0u) { if (xb_ld(&(bar)[XB_TMO])) break; if (_sp > XB_SPIN_CAP) { atomicAdd(&(bar)[XB_TMO], 1u); break; } } } } while (0)
struct XcdBarrier { unsigned* bar; unsigned x; volatile LAS unsigned* st; };
__device__ __forceinline__ XcdBarrier xcd_barrier_post(unsigned* bar, volatile LAS unsigned* st) {
    XcdBarrier b; b.bar = bar; b.x = xb_xcc_id(); b.st = st;
    if (threadIdx.x == 0) (void)xb_add(&bar[XB_XCNT(b.x)], 1u);
    return b;
}
__device__ __forceinline__ void xcd_barrier_complete(unsigned* bar, unsigned x, unsigned& nloc, unsigned& nx) {
    const unsigned G = gridDim.x * gridDim.y * gridDim.z;
    unsigned sum, cnt, mine, sp = 0u;
    for (;;) {
        sum = 0u; cnt = 0u; mine = 0u;
#pragma unroll
        for (unsigned j = 0; j < 16; ++j) { const unsigned c = xb_ld(&bar[XB_XCNT(j)]); sum += c; cnt += (c > 0u) ? 1u : 0u; mine = (j == x) ? c : mine; }
        if (sum == G) break;
        __builtin_amdgcn_s_sleep(1);
        if ((++sp & 255u) == 0u) { if (xb_ld(&bar[XB_TMO])) break; if (sp > XB_SPIN_CAP) { atomicAdd(&bar[XB_TMO], 1u); break; } }
    }
    nloc = mine > 0u ? mine : 1u; nx = cnt > 0u ? cnt : 1u;
}
__device__ __forceinline__ void xcd_barrier(const XcdBarrier& b) {
    asm volatile("s_waitcnt vmcnt(0)" ::: "memory");
    __syncthreads();
    if (threadIdx.x == 0) {
        unsigned* bar = b.bar;
        __builtin_amdgcn_s_waitcnt(0);
        unsigned nloc = b.st[0], nx = b.st[1];
        if (nloc == 0u) { xcd_barrier_complete(bar, b.x, nloc, nx); b.st[0] = nloc; b.st[1] = nx; }
        const unsigned old = xb_add(&bar[XB_XSUB(b.x)], 1u);
        const unsigned gen = old / nloc;
        if (old + 1u == (gen + 1u) * nloc) {
            __builtin_amdgcn_fence(__ATOMIC_RELEASE, "agent");
            asm volatile("s_waitcnt vmcnt(0)" ::: "memory");
            const unsigned og = xb_add(&bar[XB_TOP], 1u);
            const unsigned tg = og / nx;
            if (og + 1u == (tg + 1u) * nx) xb_add(&bar[XB_TOPGEN], 1u);
            else XB_SPIN(xb_ld(&bar[XB_TOPGEN]) == tg, bar);
            __builtin_amdgcn_fence(__ATOMIC_ACQUIRE, "agent");
            xb_add(&bar[XB_XGEN(b.x)], 1u);
            asm volatile("s_waitcnt vmcnt(0)" ::: "memory");
        } else {
            XB_SPIN(xb_ld(&bar[XB_XGEN(b.x)]) == gen, bar);
            __builtin_amdgcn_fence(__ATOMIC_ACQUIRE, "agent");
            asm volatile("s_waitcnt vmcnt(0)" ::: "memory");
        }
    }
    __syncthreads();
}

namespace pg8 {
constexpr int BM = 256, BK = 64, HALF = 128, HTB = HALF * BK * 2, STAGE_BYTES = 8 * HTB, NXCD = 8, WGM = 8;
__host__ __device__ __forceinline__ int lds_byte(int r, int c) { const int st = (r >> 4) * 2 + (c >> 5), rr = r & 15, cc = c & 31, ob = rr * 64 + cc * 2; return st * 1024 + (ob ^ (((ob >> 9) & 1) << 5)); }
__host__ __device__ __forceinline__ void stage_rc(int b, int& R, int& C) { const int st = b / 1024, sb = b % 1024, swz = sb ^ (((sb >> 9) & 1) << 5); R = (st >> 1) * 16 + swz / 64; C = (st & 1) * 32 + (swz % 64) / 2; }
__host__ __device__ __forceinline__ int perm32(int rho) { const int n = rho >> 4, i = rho & 15; return 8 * (i >> 2) + 4 * n + (i & 3); }

struct Unit { int pm, pn, e; };

struct DenseSched {
    const char* A; const char* Bt; int K; int rowb; int nM, nN, nwg, G, c;
    __device__ __forceinline__ void init(const void* A_, const void* Bt_, int M, int N, int K_, int G_, int c_) { A = (const char*)A_; Bt = (const char*)Bt_; K = K_; rowb = K_ * 2; nM = M / BM; nN = N / BM; nwg = nM * nN; G = G_; c = c_; }
    __device__ __forceinline__ bool next(int i, Unit& u) const {
        const long L = (long)i * G + c; if (L >= nwg) return false;
        int wgid = (int)L; { const int q = nwg / NXCD, r = nwg % NXCD, xcd = wgid % NXCD, off = wgid / NXCD; wgid = (xcd < r ? xcd * (q + 1) : r * (q + 1) + (xcd - r) * q) + off; }
        const int nig = WGM * nN, gid = wgid / nig, fm = gid * WGM, gsz = (nM - fm) < WGM ? (nM - fm) : WGM;
        u.pm = fm + ((wgid % nig) % gsz); u.pn = (wgid % nig) / gsz; u.e = 0; return true;
    }
    __device__ __forceinline__ const char* a_ptr(const Unit& u) const { return A + (size_t)u.pm * BM * rowb; }
    __device__ __forceinline__ const char* b_ptr(const Unit& u) const { return Bt + (size_t)u.pn * BM * rowb; }
    __device__ __forceinline__ void a_off(const Unit&, const int (&R)[2], const int (&C)[2], unsigned (&v)[2][2]) const {
#pragma unroll
        for (int h = 0; h < 2; ++h)
#pragma unroll
            for (int i = 0; i < 2; ++i) v[h][i] = (unsigned)((h * HALF + R[i]) * rowb + C[i] * 2);
    }
};

template <bool GATHER> struct MoeSched {
    const char* A; const char* Bt; size_t bstride; int K; int rowb; int npn; const LAS int* tstart; const int* cnt; const int* tokl; int total, G, c;
    __device__ __forceinline__ bool next(int i, Unit& u) const {
        const long L = (long)i * G + c; if (L >= total) return false;
        const int rt = (int)L / npn; u.pm = rt; u.pn = (int)L % npn;
        int lo = 0, hi = NE;
#pragma unroll
        for (int it = 0; it < 7; ++it) { const int mid = (lo + hi + 1) >> 1; if (tstart[mid] <= rt) lo = mid; else hi = mid - 1; }
        u.e = __builtin_amdgcn_readfirstlane(lo); u.pm = __builtin_amdgcn_readfirstlane(u.pm); u.pn = __builtin_amdgcn_readfirstlane(u.pn); return true;
    }
    __device__ __forceinline__ const char* a_ptr(const Unit& u) const { return GATHER ? A : A + (size_t)u.pm * BM * rowb; }
    __device__ __forceinline__ const char* b_ptr(const Unit& u) const { return Bt + (size_t)u.e * bstride + (size_t)u.pn * BM * rowb; }
    __device__ __forceinline__ void a_off(const Unit& u, const int (&R)[2], const int (&C)[2], unsigned (&v)[2][2]) const {
        if constexpr (GATHER) {
            const int base = (u.pm - tstart[u.e]) * BM; const int n = (u.e < NE) ? cnt[u.e] : T;
#pragma unroll
            for (int h = 0; h < 2; ++h)
#pragma unroll
                for (int i = 0; i < 2; ++i) { const int slot = base + h * HALF + R[i]; int tok = 0;
                    if (slot < n) tok = (u.e < NE) ? tokl[u.e * T + slot] : slot;
                    v[h][i] = (unsigned)(tok * rowb + C[i] * 2); }
        } else {
#pragma unroll
            for (int h = 0; h < 2; ++h)
#pragma unroll
                for (int i = 0; i < 2; ++i) v[h][i] = (unsigned)((h * HALF + R[i]) * rowb + C[i] * 2);
        }
    }
};

template <class Epi, class Sched, bool FP8 = false>
__device__ __forceinline__ void gemm_phase(LAS unsigned char* lds, const Sched& S, const Epi& E) {
    const int tid = threadIdx.x, wid = __builtin_amdgcn_readfirstlane(tid >> 6), lane = tid & 63, wr = wid >> 2, wc = wid & 3, fr = lane & 15, fq = lane >> 4;
    const int rowb = S.rowb, nt = rowb / (BK * 2);
    int R[2], C[2]; unsigned voffB[2];
#pragma unroll
    for (int i = 0; i < 2; ++i) { stage_rc(tid * 16 + i * 8192, R[i], C[i]); const int Rb = Epi::PERM ? ((R[i] & ~31) + perm32(R[i] & 31)) : R[i]; voffB[i] = (unsigned)(Rb * rowb + C[i] * 2); }
    const size_t kstep = (size_t)(BK * 2);
    const size_t hstep = (size_t)HALF * rowb;
    const unsigned ldsw = (unsigned)wid * 1024u;
    const int aoff = lds_byte(wr * 64 + fr, fq * 8), boff = lds_byte(wc * 32 + fr, fq * 8);
#define PG8_SA(b, h) (((b) * 2 + (h)) * HTB)
#define PG8_SB(b, h) ((4 + (b) * 2 + (h)) * HTB)
#define PG8_STAGE(bufoff, gbase, voff) do { _Pragma("unroll") for (int _i = 0; _i < 2; ++_i) \
        __builtin_amdgcn_global_load_lds((const unsigned*)((const char*)(gbase) + (voff)[_i]), (LAS unsigned*)(lds + (bufoff) + ldsw + _i * 8192), 16, 0, 0); } while (0)
#define PG8_LDA(dst, b, h) do { if constexpr (FP8) { _Pragma("unroll") for (int m = 0; m < 4; ++m) { const i32x4 x0_ = *(const LAS i32x4*)(lds + PG8_SA(b, h) + aoff + m * 2048), x1_ = *(const LAS i32x4*)(lds + PG8_SA(b, h) + aoff + m * 2048 + 1024); \
            dst##8[m] = __builtin_shufflevector(x0_, x1_, 0, 1, 2, 3, 4, 5, 6, 7); } } \
        else { _Pragma("unroll") for (int m = 0; m < 4; ++m) _Pragma("unroll") for (int k = 0; k < 2; ++k) dst[m][k] = *(const LAS bf16x8*)(lds + PG8_SA(b, h) + aoff + m * 2048 + k * 1024); } } while (0)
#define PG8_LDB(dst, b, h) do { if constexpr (FP8) { _Pragma("unroll") for (int n = 0; n < 2; ++n) { const i32x4 x0_ = *(const LAS i32x4*)(lds + PG8_SB(b, h) + boff + n * 2048), x1_ = *(const LAS i32x4*)(lds + PG8_SB(b, h) + boff + n * 2048 + 1024); \
            dst##8[n] = __builtin_shufflevector(x0_, x1_, 0, 1, 2, 3, 4, 5, 6, 7); } } \
        else { _Pragma("unroll") for (int n = 0; n < 2; ++n) _Pragma("unroll") for (int k = 0; k < 2; ++k) dst[n][k] = *(const LAS bf16x8*)(lds + PG8_SB(b, h) + boff + n * 2048 + k * 1024); } } while (0)
#define PG8_MMA(ai, bj, At, Bt) do { __builtin_amdgcn_s_setprio(1); _Pragma("unroll") for (int m = 0; m < 4; ++m) _Pragma("unroll") for (int n = 0; n < 2; ++n) { \
        if constexpr (FP8)   \
            asm("v_mfma_scale_f32_16x16x128_f8f6f4 %0, %1, %2, %0, %3, %3 op_sel_hi:[0,0,0]" : "+v"(acc[ai][bj][m][n]) : "v"(Bt##8[n]), "v"(At##8[m]), "v"(one_e8m0));   \
        else { _Pragma("unroll") for (int k = 0; k < 2; ++k) acc[ai][bj][m][n] = __builtin_amdgcn_mfma_f32_16x16x32_bf16(Bt[n][k], At[m][k], acc[ai][bj][m][n], 0, 0, 0); } } __builtin_amdgcn_s_setprio(0); } while (0)
#define PG8_WAIT_V(n) asm volatile("s_waitcnt vmcnt(" #n ")" ::: "memory")
#define PG8_WAIT_L(n) asm volatile("s_waitcnt lgkmcnt(" #n ")" ::: "memory")
#define PG8_BAR __builtin_amdgcn_s_barrier()
#define PG8_SCHED __builtin_amdgcn_sched_barrier(0)
    Unit cur, nxt; int ui = 0;
    if (!S.next(0, cur)) return;
    f32x4 acc[2][2][4][2];
#pragma unroll
    for (int a = 0; a < 2; ++a)
#pragma unroll
        for (int b = 0; b < 2; ++b)
#pragma unroll
            for (int m = 0; m < 4; ++m)
#pragma unroll
                for (int n = 0; n < 2; ++n) acc[a][b][m][n] = (f32x4){0.f, 0.f, 0.f, 0.f};
    bf16x8 At[4][2], B0[2][2], B1[2][2];
    i32x8 At8[4], B08[2], B18[2];
    const int one_e8m0 = 0x7F7F7F7F;
    unsigned cv[2][2], nv[2][2];
    S.a_off(cur, R, C, cv);
    const char* cA = S.a_ptr(cur); const char* cB = S.b_ptr(cur);
    PG8_STAGE(PG8_SB(0, 0), cB, voffB); PG8_STAGE(PG8_SB(0, 1), cB + hstep, voffB); PG8_STAGE(PG8_SA(0, 0), cA, cv[0]); PG8_STAGE(PG8_SA(0, 1), cA, cv[1]);
    if (wr == 1) PG8_BAR;
    PG8_WAIT_V(2); PG8_BAR;
    PG8_STAGE(PG8_SB(1, 0), cB + kstep, voffB); PG8_STAGE(PG8_SA(1, 0), cA + kstep, cv[0]); PG8_STAGE(PG8_SB(1, 1), cB + hstep + kstep, voffB);
    PG8_WAIT_V(6); PG8_BAR;
    for (;;) {
        const bool has_next = S.next(ui + 1, nxt);
        const char* nA = has_next ? S.a_ptr(nxt) : cA; const char* nB = has_next ? S.b_ptr(nxt) : cB;
        if (has_next) S.a_off(nxt, R, C, nv);
        else {
#pragma unroll
            for (int h = 0; h < 2; ++h)
#pragma unroll
                for (int i = 0; i < 2; ++i) nv[h][i] = cv[h][i]; }
        for (int t = 0; t < nt; t += 2) {
            const bool last = (t == nt - 2);
            const char* a1 = cA + (size_t)(t + 1) * kstep;
            const char* a2 = last ? nA : cA + (size_t)(t + 2) * kstep; const char* b2 = last ? nB : cB + (size_t)(t + 2) * kstep;
            const char* a3 = a2 + kstep; const char* b3 = b2 + kstep;
            unsigned v2[2][2];
#pragma unroll
            for (int h = 0; h < 2; ++h)
#pragma unroll
                for (int i = 0; i < 2; ++i) v2[h][i] = last ? nv[h][i] : cv[h][i];
            PG8_LDB(B0, 0, 0); PG8_LDB(B1, 0, 1); PG8_SCHED; PG8_LDA(At, 0, 0); PG8_STAGE(PG8_SA(1, 1), a1, cv[1]);
            PG8_WAIT_V(8); PG8_WAIT_L(0); PG8_BAR; PG8_MMA(0, 0, At, B0); PG8_MMA(0, 1, At, B1); PG8_BAR; PG8_SCHED;
            PG8_LDA(At, 0, 1); PG8_STAGE(PG8_SB(0, 0), b2, voffB); PG8_STAGE(PG8_SB(0, 1), b2 + hstep, voffB); PG8_STAGE(PG8_SA(0, 0), a2, v2[0]);
            PG8_WAIT_V(8); PG8_WAIT_L(0); PG8_BAR; PG8_MMA(1, 0, At, B0); PG8_MMA(1, 1, At, B1); PG8_BAR; PG8_SCHED;
            PG8_LDB(B0, 1, 0); PG8_LDB(B1, 1, 1); PG8_SCHED; PG8_LDA(At, 1, 0); PG8_STAGE(PG8_SA(0, 1), a2, v2[1]);
            PG8_WAIT_V(8); PG8_WAIT_L(0); PG8_BAR; PG8_MMA(0, 0, At, B0); PG8_MMA(0, 1, At, B1); PG8_BAR; PG8_SCHED;
            PG8_LDA(At, 1, 1); PG8_STAGE(PG8_SB(1, 0), b3, voffB); PG8_STAGE(PG8_SB(1, 1), b3 + hstep, voffB); PG8_STAGE(PG8_SA(1, 0), a3, v2[0]);
            PG8_WAIT_V(8); PG8_WAIT_L(0); PG8_BAR; PG8_MMA(1, 0, At, B0); PG8_MMA(1, 1, At, B1); PG8_BAR; PG8_SCHED;
        }
        if constexpr (FP8) asm volatile("s_nop 15\n\ts_nop 15" ::: "memory");
        if (wr == 0) PG8_BAR;
        E(acc, cur, wr, wc, fr, fq);
        if (!has_next) break;
#pragma unroll
        for (int a = 0; a < 2; ++a)
#pragma unroll
            for (int b = 0; b < 2; ++b)
#pragma unroll
                for (int m = 0; m < 4; ++m)
#pragma unroll
                    for (int n = 0; n < 2; ++n) acc[a][b][m][n] = (f32x4){0.f, 0.f, 0.f, 0.f};
        cur = nxt; cA = nA; cB = nB; ++ui;
#pragma unroll
        for (int h = 0; h < 2; ++h)
#pragma unroll
            for (int i = 0; i < 2; ++i) cv[h][i] = nv[h][i];
        if (wr == 1) PG8_BAR;
    }
    PG8_WAIT_V(0);
    PG8_BAR;
#undef PG8_SA
#undef PG8_SB
#undef PG8_STAGE
#undef PG8_LDA
#undef PG8_LDB
#undef PG8_MMA
#undef PG8_WAIT_V
#undef PG8_WAIT_L
#undef PG8_BAR
#undef PG8_SCHED
}
}
using pg8::Unit;

typedef const f32x4 (&AccRef)[2][2][4][2];

template <int ACT> __device__ __forceinline__ void store_tile_bf16(AccRef acc, bf16_t* O, int ld, size_t row0, int col0, int wr, int wc, int fr, int fq) {
#pragma unroll
    for (int ai = 0; ai < 2; ++ai)
#pragma unroll
        for (int m = 0; m < 4; ++m) { bf16_t* rowp = O + (row0 + ai * 128 + wr * 64 + m * 16 + fr) * (size_t)ld + col0 + wc * 32 + 8 * fq;
#pragma unroll
            for (int bj = 0; bj < 2; ++bj) { f32x4 v0 = acc[ai][bj][m][0], v1 = acc[ai][bj][m][1];
                if (ACT == 1) {
#pragma unroll
                    for (int j = 0; j < 4; ++j) { v0[j] = fast_sigmoid(v0[j]); v1[j] = fast_sigmoid(v1[j]); } }
                u32x4 w; w.x = cvt_pk_bf16(v0[0], v0[1]); w.y = cvt_pk_bf16(v0[2], v0[3]); w.z = cvt_pk_bf16(v1[0], v1[1]); w.w = cvt_pk_bf16(v1[2], v1[3]);
                *(u32x4*)(rowp + bj * 128) = w; } }
}

struct EpiInProj {
    static constexpr bool PERM = true;
    unsigned char* ws;
    __device__ __forceinline__ void operator()(AccRef acc, const Unit& u, int wr, int wc, int fr, int fq) const {
        const int pn = u.pn; const size_t row0 = (size_t)u.pm * 256;
        size_t boff; int ld, col0; bool sig = false;
        if (pn < 4) { boff = WS_Q; ld = AW; col0 = pn * 256; }
        else if (pn == 4) { boff = WS_K; ld = 256; col0 = 0; }
        else if (pn == 5) { boff = WS_V; ld = 256; col0 = 0; }
        else if (pn < 10) { boff = WS_QI; ld = 1024; col0 = (pn - 6) * 256; }
        else if (pn == 10) { boff = WS_MISC; ld = 256; col0 = 0; }
        else if (pn < 15) { boff = WS_CB; ld = CW; col0 = (pn - 11) * 256; }
        else if (pn < 19) { boff = WS_CC; ld = CW; col0 = (pn - 15) * 256; }
        else if (pn < 23) { boff = WS_CH; ld = CW; col0 = (pn - 19) * 256; }
        else if (pn < 31) { boff = WS_SA; ld = D; col0 = (pn - 23) * 256; sig = true; }
        else { boff = WS_SB; ld = D; col0 = (pn - 31) * 256; sig = true; }
        if (pn == 10) {
            if (wc < 2) { bf16_t* KIo = (bf16_t*)(ws + WS_MISC);
#pragma unroll
                for (int ai = 0; ai < 2; ++ai)
#pragma unroll
                    for (int m = 0; m < 4; ++m) { const f32x4 v0 = acc[ai][0][m][0], v1 = acc[ai][0][m][1];
                        u32x4 w; w.x = cvt_pk_bf16(v0[0], v0[1]); w.y = cvt_pk_bf16(v0[2], v0[3]); w.z = cvt_pk_bf16(v1[0], v1[1]); w.w = cvt_pk_bf16(v1[2], v1[3]);
                        const size_t key = row0 + ai * 128 + wr * 64 + m * 16 + fr;
                        *(u32x4*)(KIo + (((key >> 4) * 2 + wc) * 64 + fr + 16 * fq) * 8) = w; } }
        }
        else if (sig) store_tile_bf16<1>(acc, (bf16_t*)(ws + boff), ld, row0, col0, wr, wc, fr, fq);
        else store_tile_bf16<0>(acc, (bf16_t*)(ws + boff), ld, row0, col0, wr, wc, fr, fq);
        if (pn == 10 && wc == 2 && fq < 2) {
            float* WI = (float*)(ws + WS_WI);
#pragma unroll
            for (int ai = 0; ai < 2; ++ai)
#pragma unroll
                for (int m = 0; m < 4; ++m) { float* rp = WI + (row0 + ai * 128 + wr * 64 + m * 16 + fr) * 16 + 8 * fq;
                    *(f32x4*)(rp) = acc[ai][0][m][0] * 0.03125f; *(f32x4*)(rp + 4) = acc[ai][0][m][1] * 0.03125f; }
        }
    }
};
struct EpiPlain {
    static constexpr bool PERM = true;
    bf16_t* O; int ld;
    __device__ __forceinline__ void operator()(AccRef acc, const Unit& u, int wr, int wc, int fr, int fq) const {
        store_tile_bf16<0>(acc, O, ld, (size_t)u.pm * 256, u.pn * 256, wr, wc, fr, fq);
    }
};
struct EpiY8 {
    static constexpr bool PERM = true;
    unsigned char* O; float sc;
    __device__ __forceinline__ void operator()(AccRef acc, const Unit& u, int wr, int wc, int fr, int fq) const {
#pragma unroll
        for (int ai = 0; ai < 2; ++ai)
#pragma unroll
            for (int m = 0; m < 4; ++m) { unsigned char* rowp = O + ((size_t)u.pm * 256 + ai * 128 + wr * 64 + m * 16 + fr) * (size_t)D + u.pn * 256 + wc * 32 + 8 * fq;
#pragma unroll
                for (int bj = 0; bj < 2; ++bj) { const f32x4 v0 = acc[ai][bj][m][0] * sc, v1 = acc[ai][bj][m][1] * sc;
                    u32x2 w; w.x = pk4_fp8(v0[0], v0[1], v0[2], v0[3]); w.y = pk4_fp8(v1[0], v1[1], v1[2], v1[3]);
                    *(u32x2*)(rowp + bj * 128) = w; } }
    }
};
template <bool ADD> struct EpiGate {
    static constexpr bool PERM = true;
    const bf16_t* G; const bf16_t* P; bf16_t* O;
    __device__ __forceinline__ void operator()(AccRef acc, const Unit& u, int wr, int wc, int fr, int fq) const {
#pragma unroll
        for (int ai = 0; ai < 2; ++ai)
#pragma unroll
            for (int m = 0; m < 4; ++m) { const size_t off = ((size_t)u.pm * 256 + ai * 128 + wr * 64 + m * 16 + fr) * D + u.pn * 256 + wc * 32 + 8 * fq;
#pragma unroll
                for (int bj = 0; bj < 2; ++bj) { f32x4 v0 = acc[ai][bj][m][0], v1 = acc[ai][bj][m][1];
                    const u32x4 g = *(const u32x4*)(G + off + bj * 128);
                    v0[0] *= bflo(g.x); v0[1] *= bfhi(g.x); v0[2] *= bflo(g.y); v0[3] *= bfhi(g.y); v1[0] *= bflo(g.z); v1[1] *= bfhi(g.z); v1[2] *= bflo(g.w); v1[3] *= bfhi(g.w);
                    if (ADD) { const u32x4 p = *(const u32x4*)(P + off + bj * 128);
                        v0[0] += bflo(p.x); v0[1] += bfhi(p.x); v0[2] += bflo(p.y); v0[3] += bfhi(p.y); v1[0] += bflo(p.z); v1[1] += bfhi(p.z); v1[2] += bflo(p.w); v1[3] += bfhi(p.w); }
                    u32x4 w; w.x = cvt_pk_bf16(v0[0], v0[1]); w.y = cvt_pk_bf16(v0[2], v0[3]); w.z = cvt_pk_bf16(v1[0], v1[1]); w.w = cvt_pk_bf16(v1[2], v1[3]);
                    *(u32x4*)(O + off + bj * 128) = w; } }
    }
};
struct EpiResid {
    static constexpr bool PERM = false;
    const float* X; bf16_t* O;
    __device__ __forceinline__ void operator()(AccRef acc, const Unit& u, int wr, int wc, int fr, int fq) const {
#pragma unroll
        for (int ai = 0; ai < 2; ++ai)
#pragma unroll
            for (int m = 0; m < 4; ++m) { const size_t off = ((size_t)u.pm * 256 + ai * 128 + wr * 64 + m * 16 + fr) * D + u.pn * 256 + wc * 32 + 4 * fq;
#pragma unroll
                for (int bj = 0; bj < 2; ++bj)
#pragma unroll
                    for (int n = 0; n < 2; ++n) { const f32x4 x = *(const f32x4*)(X + off + bj * 128 + n * 16); const f32x4 r = x * ALPHA + acc[ai][bj][m][n];
                        u32x2 w; w.x = cvt_pk_bf16(r[0], r[1]); w.y = cvt_pk_bf16(r[2], r[3]); *(u32x2*)(O + off + bj * 128 + n * 16) = w; } }
    }
};
struct EpiPle {
    static constexpr bool PERM = false;
    const bf16_t* H; const bf16_t* PP; bf16_t* O;
    __device__ __forceinline__ void operator()(AccRef acc, const Unit& u, int wr, int wc, int fr, int fq) const {
#pragma unroll
        for (int ai = 0; ai < 2; ++ai)
#pragma unroll
            for (int m = 0; m < 4; ++m) { const size_t off = ((size_t)u.pm * 256 + ai * 128 + wr * 64 + m * 16 + fr) * D + u.pn * 256 + wc * 32 + 4 * fq;
#pragma unroll
                for (int bj = 0; bj < 2; ++bj)
#pragma unroll
                    for (int n = 0; n < 2; ++n) { const size_t o = off + bj * 128 + n * 16; const u32x2 h = *(const u32x2*)(H + o); const u32x2 p = *(const u32x2*)(PP + o);
                        const f32x4 a = acc[ai][bj][m][n]; f32x4 r;
                        r[0] = bflo(h.x) * ALPHA + fast_sigmoid(a[0] * W8_INV) * bflo(p.x); r[1] = bfhi(h.x) * ALPHA + fast_sigmoid(a[1] * W8_INV) * bfhi(p.x);
                        r[2] = bflo(h.y) * ALPHA + fast_sigmoid(a[2] * W8_INV) * bflo(p.y); r[3] = bfhi(h.y) * ALPHA + fast_sigmoid(a[3] * W8_INV) * bfhi(p.y);
                        u32x2 w; w.x = cvt_pk_bf16(r[0], r[1]); w.y = cvt_pk_bf16(r[2], r[3]); *(u32x2*)(O + o) = w; } }
    }
};
struct EpiSwiGlu {
    static constexpr bool PERM = true;
    unsigned char* HID;
    __device__ __forceinline__ void operator()(AccRef acc, const Unit& u, int wr, int wc, int fr, int fq) const {
#pragma unroll
        for (int ai = 0; ai < 2; ++ai)
#pragma unroll
            for (int m = 0; m < 4; ++m) { unsigned char* rowp = HID + ((size_t)u.pm * 256 + ai * 128 + wr * 64 + m * 16 + fr) * EFF + u.pn * 128 + wc * 32 + 8 * fq;
                f32x4 h0, h1;
#pragma unroll
                for (int j = 0; j < 4; ++j) { const float g0 = acc[ai][0][m][0][j] * W8_INV, g1 = acc[ai][0][m][1][j] * W8_INV;
                    h0[j] = g0 * fast_sigmoid(g0) * (acc[ai][1][m][0][j] * W8_INV); h1[j] = g1 * fast_sigmoid(g1) * (acc[ai][1][m][1][j] * W8_INV); }
                u32x2 w; w.x = pk4_fp8(h0[0], h0[1], h0[2], h0[3]); w.y = pk4_fp8(h1[0], h1[1], h1[2], h1[3]);
                *(u32x2*)rowp = w; }
    }
};

struct Args { const float* in[21]; float* out; unsigned char* ws; int ph_lo, ph_hi; };

__device__ __forceinline__ const float* karg(int i) { const float* p = ((const float* const*)__builtin_amdgcn_kernarg_segment_ptr())[i]; asm volatile("" : "+s"(p)); return p; }
struct Frame {
    LAS unsigned char* lds; int tid, lane, wave, G, vcu, gw, NGW;
    unsigned char* ws;
};

__device__ __forceinline__ void transpose_item(const float* src, int ldsrc, bf16_t* dst, int K, int nvalid, LAS float* scr, int lane) {
    if (nvalid > 0) {
#pragma unroll 8
        for (int i = 0; i < 32; ++i) { const int kk = 2 * i + (lane >> 5), n = lane & 31; scr[kk * 33 + n] = (n < nvalid) ? src[(size_t)kk * ldsrc + n] : 0.f; }
    } else {
#pragma unroll 8
        for (int i = 0; i < 32; ++i) { const int kk = 2 * i + (lane >> 5), n = lane & 31; scr[kk * 33 + n] = 0.f; }
    }
    LDS_WAIT(); asm volatile("" ::: "memory");
    const int c = lane & 7;
#pragma unroll
    for (int j = 0; j < 4; ++j) { const int n = (lane >> 3) + 8 * j; const LAS float* s = scr + (8 * c) * 33 + n;
        u32x4 o; o.x = cvt_pk_bf16(s[0 * 33], s[1 * 33]); o.y = cvt_pk_bf16(s[2 * 33], s[3 * 33]); o.z = cvt_pk_bf16(s[4 * 33], s[5 * 33]); o.w = cvt_pk_bf16(s[6 * 33], s[7 * 33]);
        *(u32x4*)(dst + (size_t)n * K + 8 * c) = o; }
    LDS_WAIT(); asm volatile("" ::: "memory");
}
__device__ __forceinline__ void router_item(const float* src, bf16_t* hi, bf16_t* lo, int k0, int n0, LAS float* scr, int lane) {
#pragma unroll 8
    for (int i = 0; i < 32; ++i) { const int kk = 2 * i + (lane >> 5), n = lane & 31; scr[kk * 33 + n] = src[(size_t)(k0 + kk) * NE + n0 + n]; }
    LDS_WAIT(); asm volatile("" ::: "memory");
    const int c = lane & 7;
#pragma unroll
    for (int j = 0; j < 4; ++j) { const int n = (lane >> 3) + 8 * j; const LAS float* s = scr + (8 * c) * 33 + n;
        float w[8], r[8]; unsigned h[8];
#pragma unroll
        for (int q = 0; q < 8; ++q) { w[q] = s[q * 33]; h[q] = f2bf(w[q]); r[q] = w[q] - bf2f(h[q]); }
        u32x4 oh, ol; oh.x = h[0] | (h[1] << 16); oh.y = h[2] | (h[3] << 16); oh.z = h[4] | (h[5] << 16); oh.w = h[6] | (h[7] << 16);
        ol.x = cvt_pk_bf16(r[0], r[1]); ol.y = cvt_pk_bf16(r[2], r[3]); ol.z = cvt_pk_bf16(r[4], r[5]); ol.w = cvt_pk_bf16(r[6], r[7]);
        *(u32x4*)(hi + (size_t)(n0 + n) * D + k0 + 8 * c) = oh; *(u32x4*)(lo + (size_t)(n0 + n) * D + k0 + 8 * c) = ol; }
    LDS_WAIT(); asm volatile("" ::: "memory");
}

struct CvtItem { const float* src; bf16_t* dst; int ldsrc, K, nvalid, fp8; };
__device__ __forceinline__ void cvt_load(const CvtItem& d, f32x4 (&r)[8], int lane) {
    const int nq = lane & 7, kq = lane >> 3;
    const float* p = d.src + (size_t)(8 * kq) * d.ldsrc + 4 * nq;
    const int nv = d.nvalid - 4 * nq;
#pragma unroll
    for (int i = 0; i < 8; ++i) { f32x4 v = (f32x4){0.f, 0.f, 0.f, 0.f}; if (nv >= 4) v = __builtin_nontemporal_load((const f32x4*)(p + (size_t)i * d.ldsrc)); r[i] = v; }
}
__device__ __forceinline__ void cvt_store(const CvtItem& d, const f32x4 (&r)[8], int lane) {
    const int nq = lane & 7, kq = lane >> 3;
    if (d.fp8) { unsigned char* o8 = (unsigned char*)d.dst + (size_t)(4 * nq) * d.K + 8 * kq;
#pragma unroll
        for (int c = 0; c < 4; ++c) { u32x2 w; w.x = pk4_fp8(r[0][c] * W8_SCALE, r[1][c] * W8_SCALE, r[2][c] * W8_SCALE, r[3][c] * W8_SCALE); w.y = pk4_fp8(r[4][c] * W8_SCALE, r[5][c] * W8_SCALE, r[6][c] * W8_SCALE, r[7][c] * W8_SCALE);
            __builtin_nontemporal_store(w, (u32x2*)(o8 + (size_t)c * d.K)); }
        return; }
    bf16_t* o = d.dst + (size_t)(4 * nq) * d.K + 8 * kq;
#pragma unroll
    for (int c = 0; c < 4; ++c) { u32x4 w; w.x = cvt_pk_bf16(r[0][c], r[1][c]); w.y = cvt_pk_bf16(r[2][c], r[3][c]); w.z = cvt_pk_bf16(r[4][c], r[5][c]); w.w = cvt_pk_bf16(r[6][c], r[7][c]);
        __builtin_nontemporal_store(w, (u32x4*)(o + (size_t)c * d.K)); }
}
constexpr int CV_I_IN = (NIN_PAD / 32) * (D / 64), CV_I_A = (D / 32) * (AW / 64), CV_I_O = (D / 32) * (D / 64), CV_I_PE = (D / 32) * (PLE / 64);
constexpr int CV_I_W1E = (1024 / 32) * (D / 64), CV_I_W2E = (D / 32) * (EFF / 64), CV_I_RT = (NE / 32) * (D / 64);
constexpr int CV_N0 = CV_I_IN, CV_N1 = CV_N0 + CV_I_A, CV_N2 = CV_N1 + CV_I_A, CV_N3 = CV_N2 + CV_I_O, CV_N4 = CV_N3 + CV_I_O, CV_N5 = CV_N4 + CV_I_PE, CV_N6 = CV_N5 + 65 * CV_I_W1E, CV_N7 = CV_N6 + 65 * CV_I_W2E;
__device__ __forceinline__ CvtItem cvt_desc(const Args& a, unsigned char* ws, int it) {
    CvtItem d; d.nvalid = 32; d.fp8 = 0;
    if (it < CV_N0) {
        const int db = it / (D / 64), kb = it % (D / 64); int sc;
        if (db < 80) sc = 32 * db; else if (db < 88) { sc = 2560 + 32 * (db - 80); int nv = 80 - 32 * (db - 80); d.nvalid = nv < 0 ? 0 : (nv > 32 ? 32 : nv); if (d.nvalid == 0) sc = 2560; } else sc = 2640 + 32 * (db - 88);
        d.src = karg(2) + (size_t)(64 * kb) * IN_W + sc; d.ldsrc = IN_W; d.dst = (bf16_t*)(ws + WS_WIN) + (size_t)(32 * db) * D + 64 * kb; d.K = D;
    } else if (it < CV_N2) {
        const bool second = it >= CV_N1; const int r = it - (second ? CV_N1 : CV_N0); const int db = r / (AW / 64), kb = r % (AW / 64);
        d.src = karg(second ? 5 : 4) + (size_t)(64 * kb) * D + 32 * db; d.ldsrc = D; d.dst = (bf16_t*)(ws + (second ? WS_WB : WS_WA)) + (size_t)(32 * db) * AW + 64 * kb; d.K = AW;
    } else if (it < CV_N4) {
        const bool second = it >= CV_N3; const int r = it - (second ? CV_N3 : CV_N2); const int db = r / (D / 64), kb = r % (D / 64);
        d.src = karg(second ? 17 : 6) + (size_t)(64 * kb) * D + 32 * db; d.ldsrc = D; d.K = D;
        if (second) { d.dst = (bf16_t*)(ws + WS_WPG + (size_t)(32 * db) * D + 64 * kb); d.fp8 = 1; }
        else d.dst = (bf16_t*)(ws + WS_WO) + (size_t)(32 * db) * D + 64 * kb;
    } else if (it < CV_N5) {
        const int r = it - CV_N4; const int db = r / (PLE / 64), kb = r % (PLE / 64);
        d.src = karg(18) + (size_t)(64 * kb) * D + 32 * db; d.ldsrc = D; d.dst = (bf16_t*)(ws + WS_WPE) + (size_t)(32 * db) * PLE + 64 * kb; d.K = PLE;
    } else if (it < CV_N6) {
        const int r = it - CV_N5; const int e = r / CV_I_W1E, q = r % CV_I_W1E; const int db = q / (D / 64), kb = q % (D / 64);
        const int ntile = db >> 3, within = (db & 7) * 32; const bool up = within >= 128; const int col = ntile * 128 + (up ? within - 128 : within);
        const float* src = (e < NE) ? (karg(up ? 12 : 11) + (size_t)e * D * EFF) : karg(up ? 15 : 14);
        d.src = src + (size_t)(64 * kb) * EFF + col; d.ldsrc = EFF; d.dst = (bf16_t*)(ws + WS_W1 + ((size_t)e * 1024 + 32 * db) * D + 64 * kb); d.K = D; d.fp8 = 1;
    } else {
        const int r = it - CV_N6; const int e = r / CV_I_W2E, q = r % CV_I_W2E; const int db = q / (EFF / 64), kb = q % (EFF / 64);
        const float* src = (e < NE) ? (karg(13) + (size_t)e * EFF * D) : karg(16);
        d.src = src + (size_t)(64 * kb) * D + 32 * db; d.ldsrc = D; d.dst = (bf16_t*)(ws + WS_W2 + ((size_t)e * D + 32 * db) * EFF + 64 * kb); d.K = EFF; d.fp8 = 1;
    }
    return d;
}
#ifndef NCONV
#define NCONV 48
#endif
#ifndef CONV_SHARE
#define CONV_SHARE 60
#endif
#ifndef CONV_FRAC_P2
#define CONV_FRAC_P2 70
#endif
constexpr int CV_P0_END = (NCONV > 0) ? CV_N5 + (int)((long)(CV_N7 - CV_N5) * (100 - CONV_SHARE) / 100) : CV_N7;
constexpr int CV_SPLIT = CV_P0_END + (int)((long)(CV_N7 - CV_P0_END) * CONV_FRAC_P2 / 100);
__device__ __forceinline__ void convert_range(const Args& a, unsigned char* ws, int i0, int i1, int cw, int ncw, int lane) {
    f32x4 r0[8], r1[8], r2[8], r3[8];
    CvtItem d0, d1, d2, d3;
    int it = i0 + cw;
    if (it >= i1) return;
    const int last = i1 - 1;
#define CV_LD(d, r, k) do { int j_ = it + (k) * ncw; d = cvt_desc(a, ws, j_ < i1 ? j_ : last); cvt_load(d, r, lane); } while (0)
    CV_LD(d0, r0, 0); CV_LD(d1, r1, 1); CV_LD(d2, r2, 2); CV_LD(d3, r3, 3);
#pragma unroll 1
    for (;;) {
        __builtin_amdgcn_sched_barrier(0);
        cvt_store(d0, r0, lane); it += ncw; if (it >= i1) break;
        __builtin_amdgcn_sched_barrier(0);
        CV_LD(d0, r0, 3);
        __builtin_amdgcn_sched_barrier(0);
        cvt_store(d1, r1, lane); it += ncw; if (it >= i1) break;
        __builtin_amdgcn_sched_barrier(0);
        CV_LD(d1, r1, 3);
        __builtin_amdgcn_sched_barrier(0);
        cvt_store(d2, r2, lane); it += ncw; if (it >= i1) break;
        __builtin_amdgcn_sched_barrier(0);
        CV_LD(d2, r2, 3);
        __builtin_amdgcn_sched_barrier(0);
        cvt_store(d3, r3, lane); it += ncw; if (it >= i1) break;
        __builtin_amdgcn_sched_barrier(0);
        CV_LD(d3, r3, 3);
    }
#undef CV_LD
}

__device__ __forceinline__ void phase_convert(const Frame& F, const Args& a) {
    LAS float* scr = (LAS float*)(F.lds + F.wave * 16384);
    unsigned char* ws = F.ws;
    convert_range(a, ws, 0, CV_P0_END, F.gw, F.NGW, F.lane);
    for (int r = F.gw; r < CV_I_RT; r += F.NGW) { const int db = r / (D / 64), kb = r % (D / 64);
        router_item(karg(9), (bf16_t*)(ws + WS_RT), (bf16_t*)(ws + WS_RT) + (size_t)NE * D, 64 * kb, 32 * db, scr, F.lane); }
    { const float* x = karg(0); bf16_t* xb = (bf16_t*)(ws + WS_XB); const size_t n8 = (size_t)T * D / 8;
      for (size_t i = (size_t)blockIdx.x * NTHR + F.tid; i < n8; i += (size_t)F.G * NTHR) { const f32x4 v0 = *(const f32x4*)(x + i * 8), v1 = *(const f32x4*)(x + i * 8 + 4);
          u32x4 w; w.x = cvt_pk_bf16(v0[0], v0[1]); w.y = cvt_pk_bf16(v0[2], v0[3]); w.z = cvt_pk_bf16(v1[0], v1[1]); w.w = cvt_pk_bf16(v1[2], v1[3]); *(u32x4*)(xb + i * 8) = w; } }
    { const float* p = karg(1); bf16_t* pb = (bf16_t*)(ws + WS_PB); const size_t n8 = (size_t)T * PLE / 8;
      for (size_t i = (size_t)blockIdx.x * NTHR + F.tid; i < n8; i += (size_t)F.G * NTHR) { const f32x4 v0 = *(const f32x4*)(p + i * 8), v1 = *(const f32x4*)(p + i * 8 + 4);
          u32x4 w; w.x = cvt_pk_bf16(v0[0], v0[1]); w.y = cvt_pk_bf16(v0[2], v0[3]); w.z = cvt_pk_bf16(v1[0], v1[1]); w.w = cvt_pk_bf16(v1[2], v1[3]); *(u32x4*)(pb + i * 8) = w; } }
}

#define DPP_XADD(v, ctrl) ((v) + u2f((unsigned)__builtin_amdgcn_update_dpp(0, (int)f2u(v), (ctrl), 0xF, 0xF, true)))
__device__ __forceinline__ float wave_sum(float v) {
    v = DPP_XADD(v, 0xB1);
    v = DPP_XADD(v, 0x4E);
    v = DPP_XADD(v, 0x141);
    v = DPP_XADD(v, 0x140);
    { const auto r = __builtin_amdgcn_permlane16_swap(f2u(v), f2u(v), false, false); const unsigned a = r[0], b = r[1]; v = u2f(a) + u2f(b); }
    { const auto r = __builtin_amdgcn_permlane32_swap(f2u(v), f2u(v), false, false); const unsigned a = r[0], b = r[1]; v = u2f(a) + u2f(b); }
    return v;
}

__device__ __forceinline__ void phase_yconv(const Frame& F, const float* conv_w, int wb, int wG) {
    const bf16_t* CB = (const bf16_t*)(F.ws + WS_CB); const bf16_t* CC = (const bf16_t*)(F.ws + WS_CC); const bf16_t* CH = (const bf16_t*)(F.ws + WS_CH); bf16_t* YC = (bf16_t*)(F.ws + WS_YC);
    const int total = T * (CW / 8);
    for (int idx = wb * NTHR + F.tid; idx < total; idx += wG * NTHR) {
        const int t = idx / (CW / 8), c = (idx % (CW / 8)) * 8;
        float accv[8];
#pragma unroll
        for (int j = 0; j < 8; ++j) accv[j] = 0.f;
#pragma unroll
        for (int d = 0; d < 3; ++d) { const int tt = t - 2 + d;
            if (tt >= 0) { const u32x4 cc = *(const u32x4*)(CC + (size_t)tt * CW + c), ch = *(const u32x4*)(CH + (size_t)tt * CW + c);
                const f32x4 w0 = *(const f32x4*)(conv_w + d * CW + c), w1 = *(const f32x4*)(conv_w + d * CW + c + 4);
                accv[0] += w0[0] * (bflo(cc.x) * bflo(ch.x)); accv[1] += w0[1] * (bfhi(cc.x) * bfhi(ch.x)); accv[2] += w0[2] * (bflo(cc.y) * bflo(ch.y)); accv[3] += w0[3] * (bfhi(cc.y) * bfhi(ch.y));
                accv[4] += w1[0] * (bflo(cc.z) * bflo(ch.z)); accv[5] += w1[1] * (bfhi(cc.z) * bfhi(ch.z)); accv[6] += w1[2] * (bflo(cc.w) * bflo(ch.w)); accv[7] += w1[3] * (bfhi(cc.w) * bfhi(ch.w)); } }
        const u32x4 cb = *(const u32x4*)(CB + (size_t)t * CW + c);
        u32x4 o; o.x = cvt_pk_bf16(accv[0] * bflo(cb.x), accv[1] * bfhi(cb.x)); o.y = cvt_pk_bf16(accv[2] * bflo(cb.y), accv[3] * bfhi(cb.y));
        o.z = cvt_pk_bf16(accv[4] * bflo(cb.z), accv[5] * bfhi(cb.z)); o.w = cvt_pk_bf16(accv[6] * bflo(cb.w), accv[7] * bfhi(cb.w));
        *(u32x4*)(YC + (size_t)t * CW + c) = o;
    }
}

__device__ __forceinline__ unsigned f2key(float f) { const unsigned u = __builtin_bit_cast(unsigned, f); return (u & 0x80000000u) ? ~u : (u | 0x80000000u); }
__device__ __forceinline__ float key2f(unsigned k) { const unsigned u = (k & 0x80000000u) ? (k & 0x7fffffffu) : ~k; return __builtin_bit_cast(float, u); }
constexpr int NBIN = 1024, CAND_CAP = 128;
struct RowState { unsigned kmin, kmax; float flo, scale; int bstar, cabove, cstar, need; unsigned ncand, nout, cmin, cmax; int done, level; unsigned cmin0, cmax0; };

__device__ __forceinline__ void phase_indexer(const Frame& F, int wb, int wG) {
    const bf16_t* QI = (const bf16_t*)(F.ws + WS_QI); const bf16_t* KI = (const bf16_t*)(F.ws + WS_MISC); const float* WI = (const float*)(F.ws + WS_WI); int* SEL = (int*)(F.ws + WS_SEL);
    LAS float* sc = (LAS float*)F.lds;
    LAS unsigned* hist = (LAS unsigned*)(F.lds + LDS_AUX);
    LAS RowState* rs = (LAS RowState*)(F.lds + LDS_AUX + 16384);
    const int lane = F.lane, wave = F.wave, fr = lane & 15, fq = lane >> 4;
    constexpr int NGRP = T / 4;
    for (int gi = wb; gi < NGRP + wG; gi += wG) {
        const int rnd = gi / wG, cidx = gi % wG; const int g = (rnd & 1) ? (rnd * wG + (wG - 1 - cidx)) : gi;
        if (g >= NGRP) continue;
        const int t0 = g * 4;
        if (t0 < 256) {
            for (int q = 0; q < 4; ++q) { const int t = t0 + q; for (int i = F.tid; i <= t; i += NTHR) SEL[(size_t)t * TOPK + i] = i; }
            continue;
        }
#ifdef PROBE_SEL_RECENT
        { for (int q = 0; q < 4; ++q) { const int t = t0 + q; for (int i = F.tid; i < TOPK; i += NTHR) SEL[(size_t)t * TOPK + i] = t - i; } continue; }
#endif
        const int nkeys = t0 + 4, ntile = (nkeys + 15) >> 4;
        if (F.tid < 4) { rs[F.tid].kmin = 0xffffffffu; rs[F.tid].kmax = 0u; }
        for (int i = F.tid; i < 4 * NBIN / 4; i += NTHR) ((LAS u32x4*)hist)[i] = (u32x4){0u, 0u, 0u, 0u};
        __syncthreads();
#ifdef PROBE_DOUBLE_SCORE
        for (int rep_ = 0; rep_ < 2; ++rep_)
#endif
        {
            bf16x8 aq[4][2]; float wq[4][4];
#pragma unroll
            for (int q = 0; q < 4; ++q) {
#pragma unroll
                for (int ks = 0; ks < 2; ++ks) aq[q][ks] = *(const bf16x8*)(QI + (size_t)(t0 + q) * 1024 + fr * 64 + ks * 32 + fq * 8);
                const f32x4 w4 = *(const f32x4*)(WI + (size_t)(t0 + q) * 16 + fq * 4);
#pragma unroll
                for (int j = 0; j < 4; ++j) wq[q][j] = 0.5f * w4[j];
            }
            float vmin = __builtin_inff(), vmax = -__builtin_inff();
            const int nmine = (ntile - wave + 7) >> 3;
            const int nchunk = (nmine + 3) >> 2;
            const int nslots = nchunk * 32; const int rot = (int)(((unsigned)wb * 37u + (unsigned)rnd * 11u) % (unsigned)nslots) & ~7;
#define IDX_KT(c, u) ({ int s_ = wave + 8 * (4 * (c) + (u)) + rot; s_ = s_ >= nslots ? s_ - nslots : s_; s_; })
#define IDX_LOAD(buf, c) do { _Pragma("unroll") for (int u_ = 0; u_ < 4; ++u_) { int kt2_ = IDX_KT(c, u_); kt2_ = kt2_ < T / 16 ? kt2_ : T / 16 - 1; \
                buf[u_][0] = *(const bf16x8*)(KI + ((size_t)(kt2_ * 2) * 64 + lane) * 8); buf[u_][1] = *(const bf16x8*)(KI + ((size_t)(kt2_ * 2 + 1) * 64 + lane) * 8); } } while (0)
#define IDX_COMPUTE(buf, c) do { f32x4 d_[4][4]; \
                _Pragma("unroll") for (int u_ = 0; u_ < 4; ++u_) _Pragma("unroll") for (int q_ = 0; q_ < 4; ++q_) { f32x4 z_ = (f32x4){0.f, 0.f, 0.f, 0.f}; \
                    z_ = __builtin_amdgcn_mfma_f32_16x16x32_bf16(aq[q_][0], buf[u_][0], z_, 0, 0, 0); d_[u_][q_] = __builtin_amdgcn_mfma_f32_16x16x32_bf16(aq[q_][1], buf[u_][1], z_, 0, 0, 0); } \
                _Pragma("unroll") for (int u_ = 0; u_ < 4; ++u_) { const int kt_ = IDX_KT(c, u_); float p_[4]; \
                    _Pragma("unroll") for (int q_ = 0; q_ < 4; ++q_) { const f32x4 x_ = d_[u_][q_]; \
                        p_[q_] = wq[q_][0] * (x_[0] + __builtin_fabsf(x_[0])) + wq[q_][1] * (x_[1] + __builtin_fabsf(x_[1])) + wq[q_][2] * (x_[2] + __builtin_fabsf(x_[2])) + wq[q_][3] * (x_[3] + __builtin_fabsf(x_[3])); } \
                    const auto r02_ = __builtin_amdgcn_permlane32_swap(f2u(p_[0]), f2u(p_[2]), false, false); const unsigned r020_ = r02_[0], r021_ = r02_[1]; \
                    const auto r13_ = __builtin_amdgcn_permlane32_swap(f2u(p_[1]), f2u(p_[3]), false, false); const unsigned r130_ = r13_[0], r131_ = r13_[1]; \
                    const float a_ = u2f(r020_) + u2f(r021_), b_ = u2f(r130_) + u2f(r131_); \
                    const auto rr_ = __builtin_amdgcn_permlane16_swap(f2u(a_), f2u(b_), false, false); const unsigned rr0_ = rr_[0], rr1_ = rr_[1]; \
                    const float tot_ = u2f(rr0_) + u2f(rr1_); \
                    const int key_ = kt_ * 16 + fr; if (key_ <= t0 + fq) { vmin = fminf(vmin, tot_); vmax = fmaxf(vmax, tot_); } \
                    if (kt_ < ntile) sc[fq * 8192 + key_] = tot_; } } while (0)
            bf16x8 bA[4][2], bB[4][2];
            IDX_LOAD(bA, 0);
            for (int c = 0; c < nchunk; c += 2) {
                __builtin_amdgcn_sched_barrier(0);
                IDX_LOAD(bB, c + 1);
                __builtin_amdgcn_sched_barrier(0);
                IDX_COMPUTE(bA, c);
#ifdef PROBE_COMPUTE2
                __builtin_amdgcn_sched_barrier(0);
                IDX_COMPUTE(bA, c);
#endif
                __builtin_amdgcn_sched_barrier(0);
                IDX_LOAD(bA, c + 2);
#ifdef PROBE_LOAD2
                __builtin_amdgcn_sched_barrier(0);
                { bf16x8 bC[4][2]; IDX_LOAD(bC, c + 3); asm volatile("" :: "v"(bC[0][0]), "v"(bC[1][0]), "v"(bC[2][0]), "v"(bC[3][0]), "v"(bC[0][1]), "v"(bC[1][1]), "v"(bC[2][1]), "v"(bC[3][1])); }
#endif
                __builtin_amdgcn_sched_barrier(0);
                IDX_COMPUTE(bB, c + 1);
#ifdef PROBE_COMPUTE2
                __builtin_amdgcn_sched_barrier(0);
                IDX_COMPUTE(bB, c + 1);
#endif
            }
#undef IDX_LOAD
#undef IDX_COMPUTE
#undef IDX_KT
            if (vmin <= vmax) { lds_min(&rs[fq].kmin, f2key(vmin)); lds_max(&rs[fq].kmax, f2key(vmax)); }
        }
        __syncthreads();
        const int q = wave >> 1, half = wave & 1, t = t0 + q, N = t + 1;
        const int sub = half * 64 + lane;
        LAS float* srow = sc + q * 8192;
        LAS unsigned* hrow = hist + q * NBIN;
        const int nit = (N + 511) >> 9;
        const unsigned long long ltmask = (1ull << lane) - 1ull;
#ifdef PROBE_DOUBLE_SEL
        for (int rep_ = 0; rep_ < 2; ++rep_) {
        if (rep_) { for (int i = sub; i < NBIN / 4; i += 128) ((LAS u32x4*)hrow)[i] = (u32x4){0u, 0u, 0u, 0u}; if (sub == 0) { rs[q].kmin = rs[q].cmin0; rs[q].kmax = rs[q].cmax0; } __syncthreads(); }
#endif
        int cur = half ? TOPK : 0;
        if (sub == 0) { rs[q].flo = key2f(rs[q].kmin); const float fhi0 = key2f(rs[q].kmax); const float rg = fhi0 - rs[q].flo; rs[q].scale = (rg > 0.f) ? (float)NBIN / rg : 0.f;
            rs[q].need = TOPK; rs[q].nout = 0u; rs[q].done = 0; rs[q].level = 0; rs[q].cmin = rs[q].kmin; rs[q].cmax = rs[q].kmax; rs[q].cmin0 = rs[q].kmin; rs[q].cmax0 = rs[q].kmax; rs[q].kmin = 0xffffffffu; rs[q].kmax = 0u; rs[q].ncand = 0u; }
        __syncthreads();
        for (int level = 0; level < 40; ++level) {
            const int alldone = rs[0].done & rs[1].done & rs[2].done & rs[3].done;
            if (alldone) break;
            const bool active = !rs[q].done;
            const float flo = rs[q].flo, scale = rs[q].scale; const float fhi = key2f(rs[q].cmax);
            const bool allsame = (rs[q].cmin == rs[q].cmax);
            if (level > 0) { for (int i = sub; i < NBIN / 4; i += 128) ((LAS u32x4*)hrow)[i] = (u32x4){0u, 0u, 0u, 0u}; __syncthreads(); }
            if (active && !allsame) {
                for (int it = 0; it < nit; ++it) { const int i0 = it * 512 + sub * 4; const f32x4 s4 = *(const LAS f32x4*)(srow + i0);
#pragma unroll
                    for (int e = 0; e < 4; ++e) { const float s = s4[e];
                        if (i0 + e < N && s >= flo && s <= fhi) { const int b = (int)fminf(fmaxf((s - flo) * scale, 0.f), (float)(NBIN - 1)); lds_add(&hrow[b], 1u); } } }
            }
            __syncthreads();
            if (active && !allsame && half == 0) {
                unsigned loc = 0;
#pragma unroll
                for (int j = 0; j < 4; ++j) { const u32x4 h4 = ((const LAS u32x4*)hrow)[lane * 4 + j]; loc += (h4.x + h4.y) + (h4.z + h4.w); }
                unsigned suf = loc;
#pragma unroll
                for (int o = 1; o < 64; o <<= 1) { const unsigned v = __shfl_down(suf, o); if (lane + o < 64) suf += v; }
                const unsigned above_lane = suf - loc; const unsigned need = (unsigned)rs[q].need;
                if (above_lane < need && suf >= need) {
                    unsigned ab = above_lane; int b = lane * 16 + 15;
                    for (;; --b) { const unsigned h = hrow[b]; if (ab + h >= need) { rs[q].bstar = b; rs[q].cabove = (int)ab; rs[q].cstar = (int)h; break; } ab += h; }
                }
            }
            __syncthreads();
            if (active) {
                if (allsame) {
                    if (half == 0) {
                        unsigned need = (unsigned)rs[q].need; unsigned base = (unsigned)cur;
                        for (int i0 = 0; i0 < N && need > 0; i0 += 64) { const int i = i0 + lane; const bool m = (i < N) && (srow[i] >= flo && srow[i] <= fhi);
                            const unsigned long long mask = __ballot(m); const unsigned pos = __builtin_popcountll(mask & ltmask);
                            if (m && pos < need) SEL[(size_t)t * TOPK + base + pos] = i;
                            const unsigned c = (unsigned)__builtin_popcountll(mask); const unsigned take = c < need ? c : need; base += take; need -= take; }
                        if (lane == 0) { rs[q].done = 1; }
                    }
                } else {
                    const int bstar = rs[q].bstar, cstar = rs[q].cstar; const bool collect = cstar <= CAND_CAP;
                    unsigned lmin = 0xffffffffu, lmax = 0u;
                    for (int it = 0; it < nit; ++it) { const int i0 = it * 512 + sub * 4; const f32x4 s4 = *(const LAS f32x4*)(srow + i0);
#pragma unroll
                        for (int e = 0; e < 4; ++e) { const float s = s4[e]; const int i = i0 + e; bool em = false, cd = false;
                            if (i < N && s >= flo && s <= fhi) { const int b = (int)fminf(fmaxf((s - flo) * scale, 0.f), (float)(NBIN - 1)); em = b > bstar; cd = b == bstar; }
                            const unsigned long long me = __ballot(em); const int ne = __builtin_popcountll(me); const int rk = __builtin_popcountll(me & ltmask);
                            if (em) SEL[(size_t)t * TOPK + (half ? (cur - 1 - rk) : (cur + rk))] = i;
                            cur = half ? cur - ne : cur + ne;
                            const unsigned long long mc = __ballot(cd);
                            if (mc) {
                                if (collect) { unsigned base = 0; if (lane == 0) base = lds_add(&rs[q].ncand, (unsigned)__builtin_popcountll(mc)); base = __shfl(base, 0);
                                    if (cd) { const unsigned p = base + __builtin_popcountll(mc & ltmask); hrow[p] = __builtin_bit_cast(unsigned, s); hrow[CAND_CAP + p] = (unsigned)i; } }
                                else if (cd) { const unsigned k = f2key(s); lmin = k < lmin ? k : lmin; lmax = k > lmax ? k : lmax; }
                            } } }
                    if (!collect && lmin <= lmax) { lds_min(&rs[q].kmin, lmin); lds_max(&rs[q].kmax, lmax); }
                    if (half == 0 && lane == 0) rs[q].nout = (unsigned)cur;
                }
            }
            __syncthreads();
            if (active && !allsame) {
                const int cstar = rs[q].cstar; const int need2 = rs[q].need - rs[q].cabove;
                if (cstar <= CAND_CAP) {
                    const unsigned nout = rs[q].nout;
                    for (int i = sub; i < cstar; i += 128) { const float s = __builtin_bit_cast(float, hrow[i]); const unsigned id = hrow[CAND_CAP + i]; int rank = 0;
                        for (int j = 0; j < cstar; ++j) { const float sj = __builtin_bit_cast(float, hrow[j]); const unsigned idj = hrow[CAND_CAP + j]; rank += (sj > s || (sj == s && idj < id)) ? 1 : 0; }
                        if (rank < need2) SEL[(size_t)t * TOPK + nout + rank] = (int)id; }
                }
            }
            __syncthreads();
            if (sub == 0 && active && !allsame) {
                if (rs[q].cstar <= CAND_CAP) rs[q].done = 1;
                else {
                    rs[q].need = rs[q].need - rs[q].cabove;
                    rs[q].cmin = rs[q].kmin; rs[q].cmax = rs[q].kmax;
                    const float nlo = key2f(rs[q].kmin), nhi = key2f(rs[q].kmax); rs[q].flo = nlo; const float rg = nhi - nlo; rs[q].scale = (rg > 0.f) ? (float)NBIN / rg : 0.f;
                    rs[q].kmin = 0xffffffffu; rs[q].kmax = 0u; rs[q].ncand = 0u;
                }
            }
            __syncthreads();
        }
#ifdef PROBE_DOUBLE_SEL
        __syncthreads(); }
#endif
        __syncthreads();
    }
}

__device__ __forceinline__ void phase_attn_simple(const Frame& F) {
    const bf16_t* Q = (const bf16_t*)(F.ws + WS_Q); const bf16_t* Kb = (const bf16_t*)(F.ws + WS_K); const bf16_t* Vb = (const bf16_t*)(F.ws + WS_V); const int* SEL = (const int*)(F.ws + WS_SEL);
    bf16_t* YA = (bf16_t*)(F.ws + WS_YA);
    LAS float* qs = (LAS float*)(F.lds + F.wave * 8192);
    LAS float* ps = qs + 512;
    const int lane = F.lane;
    const float scale = 0.08838834764831845f;
#pragma unroll 1
    for (int task = F.gw; task < T * NKV; task += F.NGW) {
        const int t = task >> 1, kvh = task & 1; const int nsel = (t + 1) < TOPK ? (t + 1) : TOPK;
#pragma unroll
        for (int i = 0; i < 8; ++i) { const int e = i * 64 + lane; qs[e] = bf2f(Q[(size_t)t * AW + kvh * 512 + e]); }
        LDS_WAIT(); asm volatile("" ::: "memory");
        float mx0 = -__builtin_inff(), mx1 = mx0, mx2 = mx0, mx3 = mx0;
#pragma unroll 1
        for (int s = 0; s < 4; ++s) {
            const int pos = s * 64 + lane; const bool valid = pos < nsel; const int key = valid ? SEL[(size_t)t * TOPK + pos] : 0;
            const bf16_t* kr = Kb + (size_t)key * 256 + kvh * 128;
            float a0 = 0.f, a1 = 0.f, a2 = 0.f, a3 = 0.f;
#pragma unroll 2
            for (int c = 0; c < 16; ++c) { const u32x4 kk = *(const u32x4*)(kr + c * 8);
                const float k0 = bflo(kk.x), k1 = bfhi(kk.x), k2 = bflo(kk.y), k3 = bfhi(kk.y), k4 = bflo(kk.z), k5 = bfhi(kk.z), k6 = bflo(kk.w), k7 = bfhi(kk.w);
#define DOT8(h, acc_) { const f32x4 qa = *(const LAS f32x4*)(qs + (h) * 128 + c * 8), qb = *(const LAS f32x4*)(qs + (h) * 128 + c * 8 + 4); \
                acc_ += qa[0] * k0 + qa[1] * k1 + qa[2] * k2 + qa[3] * k3 + qb[0] * k4 + qb[1] * k5 + qb[2] * k6 + qb[3] * k7; }
                DOT8(0, a0) DOT8(1, a1) DOT8(2, a2) DOT8(3, a3)
#undef DOT8
            }
            const float ninf = -__builtin_inff();
            a0 = valid ? a0 * scale : ninf; a1 = valid ? a1 * scale : ninf; a2 = valid ? a2 * scale : ninf; a3 = valid ? a3 * scale : ninf;
            mx0 = fmaxf(mx0, a0); mx1 = fmaxf(mx1, a1); mx2 = fmaxf(mx2, a2); mx3 = fmaxf(mx3, a3);
            *(LAS f32x4*)(ps + pos * 4) = (f32x4){a0, a1, a2, a3};
        }
#pragma unroll
        for (int o = 1; o < 64; o <<= 1) { mx0 = fmaxf(mx0, __shfl_xor(mx0, o)); mx1 = fmaxf(mx1, __shfl_xor(mx1, o)); mx2 = fmaxf(mx2, __shfl_xor(mx2, o)); mx3 = fmaxf(mx3, __shfl_xor(mx3, o)); }
        LDS_WAIT(); asm volatile("" ::: "memory");
        float s0 = 0.f, s1 = 0.f, s2 = 0.f, s3 = 0.f;
#pragma unroll 1
        for (int s = 0; s < 4; ++s) { const int pos = s * 64 + lane; f32x4 l = *(const LAS f32x4*)(ps + pos * 4);
            l[0] = __builtin_amdgcn_exp2f((l[0] - mx0) * 1.4426950408889634f); l[1] = __builtin_amdgcn_exp2f((l[1] - mx1) * 1.4426950408889634f);
            l[2] = __builtin_amdgcn_exp2f((l[2] - mx2) * 1.4426950408889634f); l[3] = __builtin_amdgcn_exp2f((l[3] - mx3) * 1.4426950408889634f);
            s0 += l[0]; s1 += l[1]; s2 += l[2]; s3 += l[3];
            *(LAS f32x4*)(ps + pos * 4) = l; }
        s0 = wave_sum(s0); s1 = wave_sum(s1); s2 = wave_sum(s2); s3 = wave_sum(s3);
#ifdef PROBE_ATTN_ZERO
        const float i0 = 0.f, i1 = 0.f, i2 = 0.f, i3 = 0.f; (void)s0; (void)s1; (void)s2; (void)s3;
#else
        const float i0 = 1.0f / s0, i1 = 1.0f / s1, i2 = 1.0f / s2, i3 = 1.0f / s3;
#endif
        LDS_WAIT(); asm volatile("" ::: "memory");
        float o00 = 0.f, o01 = 0.f, o10 = 0.f, o11 = 0.f, o20 = 0.f, o21 = 0.f, o30 = 0.f, o31 = 0.f;
#pragma unroll 1
        for (int n0 = 0; n0 < nsel; n0 += 8) {
            unsigned vv[8];
#pragma unroll
            for (int j = 0; j < 8; ++j) { const int key = (n0 + j < nsel) ? SEL[(size_t)t * TOPK + n0 + j] : 0; vv[j] = *(const unsigned*)(Vb + (size_t)key * 256 + kvh * 128 + 2 * lane); }
#pragma unroll
            for (int j = 0; j < 8; ++j) { const f32x4 p = *(const LAS f32x4*)(ps + (n0 + j) * 4); const float v0 = bflo(vv[j]), v1 = bfhi(vv[j]);
                o00 += p[0] * v0; o01 += p[0] * v1; o10 += p[1] * v0; o11 += p[1] * v1; o20 += p[2] * v0; o21 += p[2] * v1; o30 += p[3] * v0; o31 += p[3] * v1; } }
        bf16_t* yo = YA + (size_t)t * AW + kvh * 512 + 2 * lane;
        *(unsigned*)(yo) = cvt_pk_bf16(o00 * i0, o01 * i0); *(unsigned*)(yo + 128) = cvt_pk_bf16(o10 * i1, o11 * i1);
        *(unsigned*)(yo + 256) = cvt_pk_bf16(o20 * i2, o21 * i2); *(unsigned*)(yo + 384) = cvt_pk_bf16(o30 * i3, o31 * i3);
        LDS_WAIT(); asm volatile("" ::: "memory");
    }
}

typedef short s16x4 __attribute__((ext_vector_type(4)));
template <int OFF> __device__ __forceinline__ s16x4 tr_read(unsigned a) { s16x4 r; asm volatile("ds_read_b64_tr_b16 %0, %1 offset:%2" : "=&v"(r) : "v"(a), "i"(OFF) : "memory"); return r; }
__device__ __forceinline__ unsigned off_b(unsigned row, unsigned ch) { return 256u * row + 16u * (ch ^ (((row & 3u) << 2) | ((row >> 2) & 3u))); }

template <int BUF> __device__ __forceinline__ void attn_pv_step(f32x4 (&oacc)[8], const unsigned (&tra)[8][2], const bf16x8 pf) {
    s16x4 lo[8], hi[8];
#pragma unroll
    for (int c = 0; c < 8; ++c) { lo[c] = tr_read<BUF * 8192>(tra[c][0]); hi[c] = tr_read<BUF * 8192>(tra[c][1]); }
    asm volatile("s_waitcnt lgkmcnt(0)" ::: "memory"); __builtin_amdgcn_sched_barrier(0);
#pragma unroll
    for (int c = 0; c < 8; ++c) { const bf16x8 a = (bf16x8){lo[c][0], lo[c][1], lo[c][2], lo[c][3], hi[c][0], hi[c][1], hi[c][2], hi[c][3]};
        oacc[c] = __builtin_amdgcn_mfma_f32_16x16x32_bf16(a, pf, oacc[c], 0, 0, 0); }
}

__device__ __forceinline__ void phase_attn_mfma(const Frame& F, int wb, int wG) {
    const bf16_t* Q = (const bf16_t*)(F.ws + WS_Q); const bf16_t* Kb = (const bf16_t*)(F.ws + WS_K); const bf16_t* Vb = (const bf16_t*)(F.ws + WS_V); const int* SEL = (const int*)(F.ws + WS_SEL);
    bf16_t* YA = (bf16_t*)(F.ws + WS_YA);
    const int lane = F.lane, fr = lane & 15, fq = lane >> 4;
    LAS unsigned char* wl = F.lds + F.wave * 16384;
    LAS int* selw = (LAS int*)(F.lds + LDS_AUX + F.wave * 1024);
    const unsigned wl_addr = (unsigned)(size_t)wl;
    unsigned tra[8][2];
    { const unsigned g = fq, q = (lane & 15) >> 2, p = lane & 3;
#pragma unroll
      for (int c = 0; c < 8; ++c)
#pragma unroll
          for (int t2 = 0; t2 < 2; ++t2) tra[c][t2] = wl_addr + off_b(8 * g + 4 * t2 + q, 2 * c + (p >> 1)) + 8 * (p & 1); }
    const float c2 = 0.08838834764831845f * 1.4426950408889634f;
#pragma unroll 1
    for (int task = wb * NWAVES + F.wave; task < T * NKV; task += wG * NWAVES) {
        const int t = task >> 1, kvh = task & 1; const int nsel = (t + 1) < TOPK ? (t + 1) : TOPK;
#pragma unroll
        for (int i = 0; i < 4; ++i) { const int pos = i * 64 + lane; selw[pos] = (pos < nsel) ? SEL[(size_t)t * TOPK + pos] : 0; }
        LDS_WAIT(); asm volatile("" ::: "memory");
        const bf16_t* Vh = Vb + kvh * 128; const bf16_t* Kh = Kb + kvh * 128;
#define ATTN_DMA(ks, buf) do { _Pragma("unroll") for (int i_ = 0; i_ < 8; ++i_) { const int row_ = 4 * i_ + fq; const int key_ = selw[(ks) * 32 + row_]; \
            const unsigned ch_ = (unsigned)fr ^ ((((unsigned)row_ & 3u) << 2) | (((unsigned)row_ >> 2) & 3u)); \
            __builtin_amdgcn_global_load_lds((const unsigned*)(Vh + (size_t)key_ * 256 + ch_ * 8), (LAS unsigned*)(wl + (buf) * 8192 + i_ * 1024), 16, 0, 0); } } while (0)
        ATTN_DMA(0, 0); ATTN_DMA(1, 1);
        bf16x8 qf[4];
#pragma unroll
        for (int ks = 0; ks < 4; ++ks) { qf[ks] = (bf16x8){0, 0, 0, 0, 0, 0, 0, 0}; if (fr < 4) qf[ks] = *(const bf16x8*)(Q + (size_t)t * AW + (kvh * 4 + fr) * 128 + ks * 32 + fq * 8); }
        f32x4 sacc[16];
#pragma unroll
        for (int tt = 0; tt < 16; ++tt) {
            const int pos = 32 * (tt >> 1) + 8 * (fr >> 2) + 4 * (tt & 1) + (fr & 3);
            const int key = selw[pos];
            const bf16_t* kr = Kh + (size_t)key * 256 + fq * 8;
            const bf16x8 k0 = *(const bf16x8*)(kr), k1 = *(const bf16x8*)(kr + 32), k2 = *(const bf16x8*)(kr + 64), k3 = *(const bf16x8*)(kr + 96);
            f32x4 d = (f32x4){0.f, 0.f, 0.f, 0.f};
            d = __builtin_amdgcn_mfma_f32_16x16x32_bf16(k0, qf[0], d, 0, 0, 0);
            d = __builtin_amdgcn_mfma_f32_16x16x32_bf16(k1, qf[1], d, 0, 0, 0);
            d = __builtin_amdgcn_mfma_f32_16x16x32_bf16(k2, qf[2], d, 0, 0, 0);
            d = __builtin_amdgcn_mfma_f32_16x16x32_bf16(k3, qf[3], d, 0, 0, 0);
            sacc[tt] = d;
        }
        float m = -__builtin_inff();
#pragma unroll
        for (int tt = 0; tt < 16; ++tt)
#pragma unroll
            for (int j = 0; j < 4; ++j) { const int pos = 32 * (tt >> 1) + 8 * fq + 4 * (tt & 1) + j; const float v = (pos < nsel) ? sacc[tt][j] : -__builtin_inff(); sacc[tt][j] = v; m = fmaxf(m, v); }
        m = fmaxf(m, __shfl_xor(m, 16)); m = fmaxf(m, __shfl_xor(m, 32));
        float sum = 0.f; const float mc = m * c2;
#pragma unroll
        for (int tt = 0; tt < 16; ++tt)
#pragma unroll
            for (int j = 0; j < 4; ++j) { const float p = __builtin_amdgcn_exp2f(sacc[tt][j] * c2 - mc); sacc[tt][j] = p; sum += p; }
        sum += __shfl_xor(sum, 16); sum += __shfl_xor(sum, 32);
        const float inv = 1.0f / sum;
        bf16x8 pf[8];
#pragma unroll
        for (int ks = 0; ks < 8; ++ks) { u32x4 w; w.x = cvt_pk_bf16(sacc[2 * ks][0], sacc[2 * ks][1]); w.y = cvt_pk_bf16(sacc[2 * ks][2], sacc[2 * ks][3]);
            w.z = cvt_pk_bf16(sacc[2 * ks + 1][0], sacc[2 * ks + 1][1]); w.w = cvt_pk_bf16(sacc[2 * ks + 1][2], sacc[2 * ks + 1][3]); pf[ks] = __builtin_bit_cast(bf16x8, w); }
        f32x4 oacc[8];
#pragma unroll
        for (int c = 0; c < 8; ++c) oacc[c] = (f32x4){0.f, 0.f, 0.f, 0.f};
#pragma unroll
        for (int ks = 0; ks < 8; ++ks) {
            if (ks < 7) asm volatile("s_waitcnt vmcnt(8)" ::: "memory"); else asm volatile("s_waitcnt vmcnt(0)" ::: "memory");
            if (ks & 1) attn_pv_step<1>(oacc, tra, pf[ks]); else attn_pv_step<0>(oacc, tra, pf[ks]);
            if (ks + 2 < 8) { if (ks & 1) ATTN_DMA(ks + 2, 1); else ATTN_DMA(ks + 2, 0); }
        }
#undef ATTN_DMA
        if (fr < 4) { bf16_t* yo = YA + (size_t)t * AW + (kvh * 4 + fr) * 128 + fq * 4;
#pragma unroll
            for (int c = 0; c < 8; ++c) { u32x2 w; w.x = cvt_pk_bf16(oacc[c][0] * inv, oacc[c][1] * inv); w.y = cvt_pk_bf16(oacc[c][2] * inv, oacc[c][3] * inv); *(u32x2*)(yo + c * 16) = w; } }
        LDS_WAIT(); asm volatile("" ::: "memory");
    }
}

#define AT_KSLOT(f) (((f) & 3) * 4096)
#define AT_FILL_K(SW, KH, tt) do { _Pragma("unroll") for (int j_ = 0; j_ < 4; ++j_) { const int r_ = 4 * j_ + fq; const int pos_ = 32 * ((tt) >> 1) + 8 * (r_ >> 2) + 4 * ((tt) & 1) + (r_ & 3); \
        const int key_ = (SW)[pos_]; const unsigned ch_ = (unsigned)fr ^ ((((unsigned)r_ & 3u) << 2) | (((unsigned)r_ >> 2) & 3u)); \
        __builtin_amdgcn_global_load_lds((const unsigned*)((KH) + (size_t)key_ * 256 + ch_ * 8), (LAS unsigned*)(wl + AT_KSLOT(tt) + j_ * 1024), 16, 0, 0); } } while (0)
#define AT_FILL_V(SW, VH, g) do { _Pragma("unroll") for (int j_ = 0; j_ < 4; ++j_) { const int row_ = 16 * ((g) & 1) + 4 * j_ + fq; const int key_ = (SW)[((g) >> 1) * 32 + row_]; \
        const unsigned ch_ = (unsigned)fr ^ ((((unsigned)row_ & 3u) << 2) | (((unsigned)row_ >> 2) & 3u)); \
        __builtin_amdgcn_global_load_lds((const unsigned*)((VH) + (size_t)key_ * 256 + ch_ * 8), (LAS unsigned*)(wl + AT_KSLOT(g) + j_ * 1024), 16, 0, 0); } } while (0)
#define AT_ISSUE(F) do { if ((F) < 16) AT_FILL_K(selc, Khc, (F)); else if ((F) < 32) AT_FILL_V(selc, Vhc, (F) - 16); else if (has_next) AT_FILL_K(seln, Khn, (F) - 32); } while (0)

__device__ __forceinline__ void phase_attn_stream(const Frame& F, int wb, int wG) {
    const bf16_t* Q = (const bf16_t*)(F.ws + WS_Q); const bf16_t* Kb = (const bf16_t*)(F.ws + WS_K); const bf16_t* Vb = (const bf16_t*)(F.ws + WS_V); const int* SEL = (const int*)(F.ws + WS_SEL);
    bf16_t* YA = (bf16_t*)(F.ws + WS_YA);
    const int lane = F.lane, fr = lane & 15, fq = lane >> 4;
    LAS unsigned char* wl = F.lds + F.wave * 16384;
    LAS int* selc = (LAS int*)(F.lds + LDS_AUX + F.wave * 2048);
    LAS int* seln = selc + 256;
    const unsigned wl_addr = (unsigned)(size_t)wl;
    unsigned tra[8][2];
    { const unsigned g = fq, q = (lane & 15) >> 2, p = lane & 3;
#pragma unroll
      for (int c = 0; c < 8; ++c)
#pragma unroll
          for (int t2 = 0; t2 < 2; ++t2) tra[c][t2] = wl_addr + off_b(8 * g + 4 * t2 + q, 2 * c + (p >> 1)) + 8 * (p & 1); }
    unsigned kra[4];
#pragma unroll
    for (int ks = 0; ks < 4; ++ks) kra[ks] = off_b((unsigned)fr, (unsigned)(4 * ks + fq));
    const float c2 = 0.08838834764831845f * 1.4426950408889634f;
    const int stride = wG * NWAVES, ntask = T * NKV;
    int task = wb * NWAVES + F.wave;
    if (task >= ntask) return;
    int t = task >> 1, kvh = task & 1; int nsel = (t + 1) < TOPK ? (t + 1) : TOPK;
#pragma unroll
    for (int i = 0; i < 4; ++i) { const int pos = i * 64 + lane; selc[pos] = (pos < nsel) ? SEL[(size_t)t * TOPK + pos] : 0; }
    bf16x8 qf[4];
#pragma unroll
    for (int ks = 0; ks < 4; ++ks) { qf[ks] = (bf16x8){0, 0, 0, 0, 0, 0, 0, 0}; if (fr < 4) qf[ks] = *(const bf16x8*)(Q + (size_t)t * AW + (kvh * 4 + fr) * 128 + ks * 32 + fq * 8); }
    LDS_WAIT(); asm volatile("" ::: "memory");
    asm volatile("" : "+v"(qf[0]), "+v"(qf[1]), "+v"(qf[2]), "+v"(qf[3]));
    const bf16_t* Khc = Kb + kvh * 128; const bf16_t* Vhc = Vb + kvh * 128;
    { const bool has_next = false; const bf16_t* Khn = Khc; AT_ISSUE(0); AT_ISSUE(1); AT_ISSUE(2); AT_ISSUE(3); (void)has_next; (void)Khn; }
#pragma unroll 1
    for (;;) {
        const int ntk = task + stride; const bool has_next = ntk < ntask;
        const int tn = has_next ? (ntk >> 1) : t, kvhn = has_next ? (ntk & 1) : kvh; const int nseln = (tn + 1) < TOPK ? (tn + 1) : TOPK;
        const bf16_t* Khn = Kb + kvhn * 128; const bf16_t* Vhn = Vb + kvhn * 128;
        int sn[4]; bf16x8 qn[4];
#pragma unroll
        for (int i = 0; i < 4; ++i) { const int pos = i * 64 + lane; sn[i] = (has_next && pos < nseln) ? SEL[(size_t)tn * TOPK + pos] : 0; }
#pragma unroll
        for (int ks = 0; ks < 4; ++ks) { qn[ks] = (bf16x8){0, 0, 0, 0, 0, 0, 0, 0}; if (has_next && fr < 4) qn[ks] = *(const bf16x8*)(Q + (size_t)tn * AW + (kvhn * 4 + fr) * 128 + ks * 32 + fq * 8); }
        f32x4 sacc[16];
#pragma unroll
        for (int tt = 0; tt < 16; ++tt) {
            asm volatile("s_waitcnt vmcnt(12)" ::: "memory");
            const LAS unsigned char* kb = wl + AT_KSLOT(tt);
            const bf16x8 k0 = *(const LAS bf16x8*)(kb + kra[0]), k1 = *(const LAS bf16x8*)(kb + kra[1]), k2 = *(const LAS bf16x8*)(kb + kra[2]), k3 = *(const LAS bf16x8*)(kb + kra[3]);
            LDS_WAIT(); asm volatile("" ::: "memory");
            AT_ISSUE(tt + 4);
            f32x4 d = (f32x4){0.f, 0.f, 0.f, 0.f};
            d = __builtin_amdgcn_mfma_f32_16x16x32_bf16(k0, qf[0], d, 0, 0, 0);
            d = __builtin_amdgcn_mfma_f32_16x16x32_bf16(k1, qf[1], d, 0, 0, 0);
            d = __builtin_amdgcn_mfma_f32_16x16x32_bf16(k2, qf[2], d, 0, 0, 0);
            d = __builtin_amdgcn_mfma_f32_16x16x32_bf16(k3, qf[3], d, 0, 0, 0);
            sacc[tt] = d;
        }
#pragma unroll
        for (int i = 0; i < 4; ++i) seln[i * 64 + lane] = sn[i];
        asm volatile("" : "+v"(qn[0]), "+v"(qn[1]), "+v"(qn[2]), "+v"(qn[3]));
        float m = -__builtin_inff();
#pragma unroll
        for (int tt = 0; tt < 16; ++tt)
#pragma unroll
            for (int j = 0; j < 4; ++j) { const int pos = 32 * (tt >> 1) + 8 * fq + 4 * (tt & 1) + j; const float v = (pos < nsel) ? sacc[tt][j] : -__builtin_inff(); sacc[tt][j] = v; m = fmaxf(m, v); }
        m = fmaxf(m, __shfl_xor(m, 16)); m = fmaxf(m, __shfl_xor(m, 32));
        float sum = 0.f; const float mc = m * c2;
#pragma unroll
        for (int tt = 0; tt < 16; ++tt)
#pragma unroll
            for (int j = 0; j < 4; ++j) { const float p = __builtin_amdgcn_exp2f(sacc[tt][j] * c2 - mc); sacc[tt][j] = p; sum += p; }
        sum += __shfl_xor(sum, 16); sum += __shfl_xor(sum, 32);
        const float inv = 1.0f / sum;
        bf16x8 pf[8];
#pragma unroll
        for (int ks = 0; ks < 8; ++ks) { u32x4 w; w.x = cvt_pk_bf16(sacc[2 * ks][0], sacc[2 * ks][1]); w.y = cvt_pk_bf16(sacc[2 * ks][2], sacc[2 * ks][3]);
            w.z = cvt_pk_bf16(sacc[2 * ks + 1][0], sacc[2 * ks + 1][1]); w.w = cvt_pk_bf16(sacc[2 * ks + 1][2], sacc[2 * ks + 1][3]); pf[ks] = __builtin_bit_cast(bf16x8, w); }
        f32x4 oacc[8];
#pragma unroll
        for (int c = 0; c < 8; ++c) oacc[c] = (f32x4){0.f, 0.f, 0.f, 0.f};
        LDS_WAIT(); asm volatile("" ::: "memory");
#pragma unroll
        for (int ks = 0; ks < 8; ++ks) {
            if (ks < 7 || has_next) asm volatile("s_waitcnt vmcnt(8)" ::: "memory"); else asm volatile("s_waitcnt vmcnt(0)" ::: "memory");
            if (ks & 1) attn_pv_step<1>(oacc, tra, pf[ks]); else attn_pv_step<0>(oacc, tra, pf[ks]);
            AT_ISSUE(20 + 2 * ks); AT_ISSUE(21 + 2 * ks);
        }
        if (fr < 4) { bf16_t* yo = YA + (size_t)t * AW + (kvh * 4 + fr) * 128 + fq * 4;
#pragma unroll
            for (int c = 0; c < 8; ++c) { u32x2 w; w.x = cvt_pk_bf16(oacc[c][0] * inv, oacc[c][1] * inv); w.y = cvt_pk_bf16(oacc[c][2] * inv, oacc[c][3] * inv); *(u32x2*)(yo + c * 16) = w; } }
        if (!has_next) break;
        task = ntk; t = tn; kvh = kvhn; nsel = nseln; Khc = Khn; Vhc = Vhn;
#pragma unroll
        for (int ks = 0; ks < 4; ++ks) qf[ks] = qn[ks];
        { LAS int* tmp = selc; selc = seln; seln = tmp; }
    }
    asm volatile("s_waitcnt vmcnt(0)" ::: "memory");
}
#undef AT_ISSUE
#undef AT_FILL_K
#undef AT_FILL_V
#undef AT_KSLOT

__device__ __forceinline__ void phase_ln1_route(const Frame& F, const float* g1, const float* b1, const float* rbias) {
    const bf16_t* PRE = (const bf16_t*)(F.ws + WS_PRE1); bf16_t* H1B = (bf16_t*)(F.ws + WS_H1B); unsigned char* H18 = F.ws + WS_H18;
    const bf16_t* RH = (const bf16_t*)(F.ws + WS_RT); const bf16_t* RL = RH + (size_t)NE * D;
    unsigned* cnt = (unsigned*)(F.ws + WS_CTL) + CW_CNT; int* TOKL = (int*)(F.ws + WS_TOKL); int* SLOT = (int*)(F.ws + WS_SLOT); float* GATE = (float*)(F.ws + WS_GATE);
    LAS bf16_t* hh = (LAS bf16_t*)F.lds;
    LAS bf16_t* hl = (LAS bf16_t*)(F.lds + 16 * 2056 * 2);
    LAS float* lg = (LAS float*)(F.lds + 2 * 16 * 2056 * 2);
    LAS float* gbuf = lg + 16 * 64;
    LAS unsigned long long* smask = (LAS unsigned long long*)(gbuf + 16 * 64);
    const int lane = F.lane, wave = F.wave, fr = lane & 15, fq = lane >> 4;
    const float bias_l = rbias[lane];
    for (int task = blockIdx.x; task < T / 16; task += F.G) {
        const int r0 = task * 16;
        int zero_; asm volatile("s_mov_b32 %0, 0" : "=s"(zero_));
        const float* g1t = g1 + zero_; const float* b1t = b1 + zero_; const bf16_t* RHt = RH + zero_; const bf16_t* RLt = RL + zero_;
        for (int i = F.tid; i < 16 * 64; i += NTHR) lg[i] = 0.f;
        {
            f32x4 v[2][8]; float s[2] = {0.f, 0.f};
#pragma unroll
            for (int rr = 0; rr < 2; ++rr) { const u32x2* xr = (const u32x2*)(PRE + (size_t)(r0 + wave * 2 + rr) * D) + lane;
#pragma unroll
                for (int j = 0; j < 8; ++j) { const u32x2 w = xr[64 * j]; v[rr][j] = (f32x4){bflo(w.x), bfhi(w.x), bflo(w.y), bfhi(w.y)}; } }
#pragma unroll
            for (int rr = 0; rr < 2; ++rr)
#pragma unroll
                for (int j = 0; j < 8; ++j) s[rr] += (v[rr][j][0] + v[rr][j][1]) + (v[rr][j][2] + v[rr][j][3]);
#pragma unroll
            for (int rr = 0; rr < 2; ++rr) {
                const int lr = wave * 2 + rr; const size_t row = (size_t)(r0 + lr);
                const float mean = wave_sum(s[rr]) * (1.f / D); float s2 = 0.f;
#pragma unroll
                for (int j = 0; j < 8; ++j) { v[rr][j] = v[rr][j] - mean; s2 += (v[rr][j][0] * v[rr][j][0] + v[rr][j][1] * v[rr][j][1]) + (v[rr][j][2] * v[rr][j][2] + v[rr][j][3] * v[rr][j][3]); }
                const float rstd = 1.0f / sqrtf(wave_sum(s2) * (1.f / D) + LN_EPS);
#pragma unroll
                for (int j = 0; j < 8; ++j) { const int c = 4 * lane + 256 * j; const f32x4 gg = *(const f32x4*)(g1t + c), bb = *(const f32x4*)(b1t + c);
                    f32x4 y; unsigned hi[4]; float lo[4];
#pragma unroll
                    for (int e = 0; e < 4; ++e) { y[e] = v[rr][j][e] * rstd * gg[e] + bb[e]; hi[e] = f2bf(y[e]); lo[e] = y[e] - bf2f(hi[e]); }
                    u32x2 wh; wh.x = hi[0] | (hi[1] << 16); wh.y = hi[2] | (hi[3] << 16);
                    *(u32x2*)(H1B + row * D + c) = wh;
                    *(unsigned*)(H18 + row * D + c) = pk4_fp8(y[0], y[1], y[2], y[3]);
                    *(LAS u32x2*)(hh + lr * 2056 + c) = wh;
                    u32x2 wl; wl.x = cvt_pk_bf16(lo[0], lo[1]); wl.y = cvt_pk_bf16(lo[2], lo[3]);
                    *(LAS u32x2*)(hl + lr * 2056 + c) = wl; }
            }
        }
        __syncthreads();
        {
            f32x4 dacc[4];
#pragma unroll
            for (int et = 0; et < 4; ++et) dacc[et] = (f32x4){0.f, 0.f, 0.f, 0.f};
#pragma unroll
            for (int kh = 0; kh < 4; ++kh) {
                bf16x8 bh[2][4], bl[2][4];
#pragma unroll
                for (int k4 = 0; k4 < 2; ++k4)
#pragma unroll
                    for (int et = 0; et < 4; ++et) { const int k0 = wave * 256 + (kh * 2 + k4) * 32 + fq * 8;
                        bh[k4][et] = *(const bf16x8*)(RHt + (size_t)(et * 16 + fr) * D + k0); bl[k4][et] = *(const bf16x8*)(RLt + (size_t)(et * 16 + fr) * D + k0); }
#pragma unroll
                for (int k4 = 0; k4 < 2; ++k4) { const int k0 = wave * 256 + (kh * 2 + k4) * 32 + fq * 8;
                    const bf16x8 ah = *(const LAS bf16x8*)(hh + fr * 2056 + k0), al = *(const LAS bf16x8*)(hl + fr * 2056 + k0);
#pragma unroll
                    for (int et = 0; et < 4; ++et) {
                        dacc[et] = __builtin_amdgcn_mfma_f32_16x16x32_bf16(ah, bh[k4][et], dacc[et], 0, 0, 0);
                        dacc[et] = __builtin_amdgcn_mfma_f32_16x16x32_bf16(ah, bl[k4][et], dacc[et], 0, 0, 0);
                        dacc[et] = __builtin_amdgcn_mfma_f32_16x16x32_bf16(al, bh[k4][et], dacc[et], 0, 0, 0); } }
            }
#pragma unroll
            for (int et = 0; et < 4; ++et)
#pragma unroll
                for (int j = 0; j < 4; ++j) lds_addf(&lg[(fq * 4 + j) * 64 + et * 16 + fr], dacc[et][j]);
        }
        __syncthreads();
#pragma unroll 1
        for (int rr = 0; rr < 2; ++rr) {
            const int lr = wave * 2 + rr;
            const float score = fast_sigmoid(lg[lr * 64 + lane]); const float biased = score + bias_l;
            int rk = 0;
#pragma unroll
            for (int o = 1; o < 8; ++o) { const int src = (lane & ~7) | ((lane + o) & 7); const float ov = __shfl(biased, src); rk += (ov > biased || (ov == biased && src < lane)) ? 1 : 0; }
            float g2 = rk < 2 ? biased : 0.f;
            g2 += __shfl_xor(g2, 1); g2 += __shfl_xor(g2, 2); g2 += __shfl_xor(g2, 4);
            int grk = 0; const int mygrp = lane >> 3;
#pragma unroll
            for (int gg = 0; gg < 8; ++gg) { const float ov = u2f((unsigned)__builtin_amdgcn_readlane((int)f2u(g2), gg * 8));
                grk += (gg != mygrp && (ov > g2 || (ov == g2 && gg < mygrp))) ? 1 : 0; }
            const float cand = grk < 4 ? biased : -__builtin_inff();
            int erk = 0;
#pragma unroll
            for (int e = 0; e < 64; ++e) { const float ov = u2f((unsigned)__builtin_amdgcn_readlane((int)f2u(cand), e)); erk += (e != lane && (ov > cand || (ov == cand && e < lane))) ? 1 : 0; }
            const bool selq = erk < 8;
            const float gsum = wave_sum(selq ? score : 0.f);
            gbuf[lr * 64 + lane] = score / gsum * 2.5f;
            const unsigned long long m = __ballot(selq);
            if (lane == 0) smask[lr] = m;
        }
        __syncthreads();
        if (wave == 0) {
            int n = 0;
#pragma unroll
            for (int tk = 0; tk < 16; ++tk) n += (int)((smask[tk] >> lane) & 1ull);
            unsigned pos = 0; if (n) pos = atomicAdd(&cnt[lane], (unsigned)n);
#pragma unroll
            for (int tk = 0; tk < 16; ++tk) { const unsigned long long m = smask[tk];
                if ((m >> lane) & 1ull) { const int tok = r0 + tk; const int k = __builtin_popcountll(m & ((1ull << lane) - 1ull));
                    TOKL[lane * T + pos] = tok; SLOT[tok * 8 + k] = (lane << 16) | (int)pos; GATE[tok * 8 + k] = gbuf[tk * 64 + lane]; ++pos; } }
        }
        __syncthreads();
    }
}

__device__ __forceinline__ void phase_ln2(const Frame& F, const float* g2, const float* b2, float* out) {
    const bf16_t* ACC2 = (const bf16_t*)(F.ws + WS_ACC2); const unsigned char* Y = F.ws + WS_Y; const int* SLOT = (const int*)(F.ws + WS_SLOT); const float* GATE = (const float*)(F.ws + WS_GATE);
    const unsigned* cnt = (const unsigned*)(F.ws + WS_CTL) + CW_CNT;
    LAS int* tstart = (LAS int*)(F.lds + LDS_AUX);
    if (F.tid == 0) { int acc = 0; for (int e = 0; e < NE; ++e) { tstart[e] = acc; acc += ((int)cnt[e] + 255) >> 8; } tstart[NE] = acc; tstart[NE + 1] = acc + T / 256; }
    __syncthreads();
    const int lane = F.lane;
    for (int row = F.gw; row < T; row += F.NGW) {
        f32x4 v[8];
        const u32x2* xr = (const u32x2*)(ACC2 + (size_t)row * D) + lane;
#pragma unroll
        for (int j = 0; j < 8; ++j) { const u32x2 w = xr[64 * j]; v[j] = (f32x4){bflo(w.x), bfhi(w.x), bflo(w.y), bfhi(w.y)}; }
        int si[8]; float gt[8];
        { const u32x4 s0 = *(const u32x4*)(SLOT + row * 8), s1 = *(const u32x4*)(SLOT + row * 8 + 4); const f32x4 g0 = *(const f32x4*)(GATE + row * 8), g1 = *(const f32x4*)(GATE + row * 8 + 4);
          si[0] = (int)s0.x; si[1] = (int)s0.y; si[2] = (int)s0.z; si[3] = (int)s0.w; si[4] = (int)s1.x; si[5] = (int)s1.y; si[6] = (int)s1.z; si[7] = (int)s1.w;
          gt[0] = g0[0]; gt[1] = g0[1]; gt[2] = g0[2]; gt[3] = g0[3]; gt[4] = g1[0]; gt[5] = g1[1]; gt[6] = g1[2]; gt[7] = g1[3]; }
#pragma unroll
        for (int kb = 0; kb < 3; ++kb) {
            unsigned w[3][8]; float g[3];
#pragma unroll
            for (int u = 0; u < 3; ++u) { const int k = kb * 3 + u; size_t yrow;
                if (k < 8) { yrow = (size_t)tstart[si[k] >> 16] * 256 + (si[k] & 0xffff); g[u] = gt[k] * Y8_INV; } else { yrow = (size_t)tstart[NE] * 256 + row; g[u] = Y8_INV; }
                const unsigned* yr = (const unsigned*)(Y + yrow * D) + lane;
#pragma unroll
                for (int j = 0; j < 8; ++j) w[u][j] = yr[64 * j]; }
#pragma unroll
            for (int u = 0; u < 3; ++u)
#pragma unroll
                for (int j = 0; j < 8; ++j) { const f32x2 lo = __builtin_amdgcn_cvt_pk_f32_fp8((int)w[u][j], false), hi = __builtin_amdgcn_cvt_pk_f32_fp8((int)w[u][j], true);
                    v[j][0] += g[u] * lo[0]; v[j][1] += g[u] * lo[1]; v[j][2] += g[u] * hi[0]; v[j][3] += g[u] * hi[1]; }
        }
        float s = 0.f;
#pragma unroll
        for (int j = 0; j < 8; ++j) s += (v[j][0] + v[j][1]) + (v[j][2] + v[j][3]);
        const float mean = wave_sum(s) * (1.f / D); float s2 = 0.f;
#pragma unroll
        for (int j = 0; j < 8; ++j) { v[j] = v[j] - mean; s2 += (v[j][0] * v[j][0] + v[j][1] * v[j][1]) + (v[j][2] * v[j][2] + v[j][3] * v[j][3]); }
        const float rstd = 1.0f / sqrtf(wave_sum(s2) * (1.f / D) + LN_EPS);
#pragma unroll
        for (int j = 0; j < 8; ++j) { const int c = 4 * lane + 256 * j; const f32x4 gg = *(const f32x4*)(g2 + c), bb = *(const f32x4*)(b2 + c);
            f32x4 y;
#pragma unroll
            for (int e = 0; e < 4; ++e) y[e] = v[j][e] * rstd * gg[e] + bb[e];
            *(f32x4*)(out + (size_t)row * D + c) = y; }
    }
}

constexpr int N_PHASES = 10;
__global__ void __launch_bounds__(NTHR, 2) fwd(Args args) {
    extern __shared__ __attribute__((aligned(16))) unsigned char lds_raw[];
    Frame F;
    F.lds = (LAS unsigned char*)lds_raw; F.tid = threadIdx.x; F.lane = F.tid & 63; F.wave = __builtin_amdgcn_readfirstlane(F.tid >> 6);
    F.G = gridDim.x; { const int bx = blockIdx.x; F.vcu = (F.G % 8 == 0) ? (bx % 8) * (F.G / 8) + bx / 8 : bx; }
    F.gw = blockIdx.x * NWAVES + F.wave; F.NGW = F.G * NWAVES; F.ws = args.ws;
    unsigned char* ws = args.ws;
    volatile LAS unsigned* MISC = (volatile LAS unsigned*)(F.lds + LDS_MISC);
    if (F.tid < 64) MISC[F.tid] = 0u;
    __syncthreads();
#if MK_N_LAUNCHES == 1
    XcdBarrier bar = xcd_barrier_post((unsigned*)(ws + WS_CTL) + CW_BAR, MISC + 8);
#define GRID_BAR() xcd_barrier(bar)
#else
#define GRID_BAR() do {} while (0)
#endif
    const int lo = args.ph_lo, hi = args.ph_hi;
#ifndef PHASE_MASK
#define PHASE_MASK 0x3ff
#endif
#define IN(k) (((PHASE_MASK >> (k)) & 1) && lo <= (k) && (k) < hi)
#define SEAM(k) do { if (IN(k) && IN((k) + 1)) GRID_BAR(); } while (0)

#ifndef PROBE_DOUBLE
#define PROBE_DOUBLE -1
#endif
#define PHASE(k, ...) do { if (IN(k)) { __VA_ARGS__ if (PROBE_DOUBLE == (k)) { GRID_BAR(); __VA_ARGS__ } SEAM(k); } } while (0)
    PHASE(0, { phase_convert(F, args); });
    PHASE(1, {
        { pg8::DenseSched S; S.init(ws + WS_XB, ws + WS_WIN, T, NIN_PAD, D, F.G, (int)blockIdx.x); EpiInProj E{ws}; pg8::gemm_phase(F.lds, S, E); }
        { pg8::DenseSched S; S.init(ws + WS_PB, ws + WS_WPE, T, D, PLE, F.G, (int)blockIdx.x); EpiPlain E{(bf16_t*)(ws + WS_PP), D}; pg8::gemm_phase(F.lds, S, E); }
    });
    const int wG = (int)F.G > 2 * NCONV ? (int)F.G - NCONV : (int)F.G; const bool is_conv = (int)blockIdx.x >= wG; const int ncw = ((int)F.G - wG) * NWAVES, cw = ((int)blockIdx.x - wG) * NWAVES + F.wave;
    PHASE(2, { if (is_conv) convert_range(args, ws, CV_P0_END, CV_SPLIT, cw, ncw, F.lane);
               else { phase_yconv(F, karg(3), (int)blockIdx.x, wG); phase_indexer(F, (int)blockIdx.x, wG); }
               if (wG == (int)F.G) convert_range(args, ws, CV_P0_END, CV_SPLIT, F.gw, F.NGW, F.lane); });
    PHASE(3, {
        { pg8::DenseSched S; S.init(ws + WS_YC, ws + WS_WB, T, D, CW, F.G, (int)blockIdx.x); EpiGate<false> E{(const bf16_t*)(ws + WS_SB), nullptr, (bf16_t*)(ws + WS_M1)}; pg8::gemm_phase(F.lds, S, E); }
        if (is_conv) convert_range(args, ws, CV_SPLIT, CV_N7, cw, ncw, F.lane);
#ifdef ATTN_V1
        else phase_attn_mfma(F, (int)blockIdx.x, wG);
#else
        else phase_attn_stream(F, (int)blockIdx.x, wG);
#endif
        if (wG == (int)F.G) convert_range(args, ws, CV_SPLIT, CV_N7, F.gw, F.NGW, F.lane);
    });
    PHASE(4, {
        pg8::DenseSched S; S.init(ws + WS_YA, ws + WS_WA, T, D, AW, F.G, (int)blockIdx.x); EpiGate<true> E{(const bf16_t*)(ws + WS_SA), (const bf16_t*)(ws + WS_M1), (bf16_t*)(ws + WS_MG)}; pg8::gemm_phase(F.lds, S, E);
    });
    PHASE(5, {
        pg8::DenseSched S; S.init(ws + WS_MG, ws + WS_WO, T, D, D, F.G, (int)blockIdx.x); EpiResid E{karg(0), (bf16_t*)(ws + WS_PRE1)}; pg8::gemm_phase(F.lds, S, E);
    });
#ifdef PROBE_DOUBLE_P6
    if (IN(6)) { phase_ln1_route(F, karg(7), karg(8), karg(10)); GRID_BAR();
        if (blockIdx.x == 0 && F.tid < NE) ((unsigned*)(ws + WS_CTL) + CW_CNT)[F.tid] = 0u;
        GRID_BAR(); }
#endif
    PHASE(6, { phase_ln1_route(F, karg(7), karg(8), karg(10)); });
    PHASE(7, {
        LAS int* tstart = (LAS int*)(F.lds + LDS_AUX);
        const unsigned* cnt = (const unsigned*)(ws + WS_CTL) + CW_CNT;
        if (F.tid == 0) { int acc = 0; for (int e = 0; e < NE; ++e) { tstart[e] = acc; acc += ((int)cnt[e] + 255) >> 8; } tstart[NE] = acc; tstart[NE + 1] = acc + T / 256; }
        __syncthreads();
        { pg8::MoeSched<true> S; S.A = (const char*)(ws + WS_H18); S.Bt = (const char*)(ws + WS_W1); S.bstride = (size_t)1024 * D; S.K = D; S.rowb = D; S.npn = 4; S.tstart = tstart; S.cnt = (const int*)cnt; S.tokl = (const int*)(ws + WS_TOKL);
          S.total = __builtin_amdgcn_readfirstlane(tstart[NE + 1]) * 4; S.G = F.G; S.c = F.vcu; EpiSwiGlu E{ws + WS_HID}; pg8::gemm_phase<EpiSwiGlu, pg8::MoeSched<true>, true>(F.lds, S, E); }
        { pg8::DenseSched S; S.init(ws + WS_H18, ws + WS_WPG, T, D, D, F.G, (int)blockIdx.x); S.rowb = D; EpiPle E{(const bf16_t*)(ws + WS_H1B), (const bf16_t*)(ws + WS_PP), (bf16_t*)(ws + WS_ACC2)}; pg8::gemm_phase<EpiPle, pg8::DenseSched, true>(F.lds, S, E); }
    });
    PHASE(8, {
        LAS int* tstart = (LAS int*)(F.lds + LDS_AUX);
        const unsigned* cnt = (const unsigned*)(ws + WS_CTL) + CW_CNT;
        if (F.tid == 0) { int acc = 0; for (int e = 0; e < NE; ++e) { tstart[e] = acc; acc += ((int)cnt[e] + 255) >> 8; } tstart[NE] = acc; tstart[NE + 1] = acc + T / 256; }
        __syncthreads();
        pg8::MoeSched<false> S; S.A = (const char*)(ws + WS_HID); S.Bt = (const char*)(ws + WS_W2); S.bstride = (size_t)D * EFF; S.K = EFF; S.rowb = EFF; S.npn = 8; S.tstart = tstart; S.cnt = (const int*)cnt; S.tokl = nullptr;
        S.total = __builtin_amdgcn_readfirstlane(tstart[NE + 1]) * 8; S.G = F.G; S.c = F.vcu; EpiY8 E{ws + WS_Y, Y8_SCALE * W8_INV}; pg8::gemm_phase<EpiY8, pg8::MoeSched<false>, true>(F.lds, S, E);
    });
    PHASE(9, { phase_ln2(F, karg(19), karg(20), (float*)karg(21)); });
}

extern "C" void kernel_launch(void* const* d_in, const int* in_sizes, int n_in, void* d_out, int out_size, void* d_ws, size_t ws_size, hipStream_t stream) {
    static int grid = 0;
    if (!grid) {
        if (n_in != 21 || ws_size < WS_END) { fprintf(stderr, "kernel_launch: unexpected n_in %d / ws_size %zu (need %zu)\n", n_in, ws_size, (size_t)WS_END); grid = -1; return; }
        int dev = 0, cus = 0, per_cu = 0;
        hipGetDevice(&dev); hipDeviceGetAttribute(&cus, hipDeviceAttributeMultiprocessorCount, dev);
        if (hipFuncSetAttribute((const void*)fwd, hipFuncAttributeMaxDynamicSharedMemorySize, LDS_BYTES) != hipSuccess) { fprintf(stderr, "kernel_launch: hipFuncSetAttribute failed\n"); grid = -1; return; }
        hipOccupancyMaxActiveBlocksPerMultiprocessor(&per_cu, (const void*)fwd, NTHR, LDS_BYTES);
        if (per_cu < 1) fprintf(stderr, "kernel_launch: occupancy query says %d\n", per_cu);
        grid = cus;
    }
    if (grid <= 0) return;
    hipMemsetAsync((char*)d_ws + WS_CTL, 0, CTL_BYTES, stream);
    Args a{};
    for (int i = 0; i < 21; ++i) a.in[i] = (const float*)d_in[i];
    a.out = (float*)d_out; a.ws = (unsigned char*)d_ws;
#if MK_N_LAUNCHES == 1
    a.ph_lo = 0; a.ph_hi = N_PHASES;
    hipLaunchKernelGGL(fwd, dim3(grid), dim3(NTHR), LDS_BYTES, stream, a);
#else
    for (int p = 0; p < N_PHASES; ++p) { a.ph_lo = p; a.ph_hi = p + 1; hipLaunchKernelGGL(fwd, dim3(grid), dim3(NTHR), LDS_BYTES, stream, a); }
#endif
}
```

```cpp
#include <hip/hip_runtime.h>
#include <cstdio>
#include <cstdint>

#ifndef MK_N_LAUNCHES
#define MK_N_LAUNCHES 1
#endif

#define GAS __attribute__((address_space(1)))
#define LAS __attribute__((address_space(3)))
typedef unsigned short bf16_t;
typedef short bf16x8 __attribute__((ext_vector_type(8)));
typedef float f32x4 __attribute__((ext_vector_type(4)));
typedef float f32x2 __attribute__((ext_vector_type(2)));
typedef unsigned u32x4 __attribute__((ext_vector_type(4)));
typedef unsigned u32x2 __attribute__((ext_vector_type(2)));
typedef long l64x2 __attribute__((ext_vector_type(2)));
typedef int i32x4 __attribute__((ext_vector_type(4)));
typedef int i32x8 __attribute__((ext_vector_type(8)));

constexpr int T = 8192, D = 2048;
constexpr int NH = 8, NKV = 2, HD = 128, AW = 1024;
constexpr int IH = 16, IDIM = 64, TOPK = 256;
constexpr int CW = 1024;
constexpr int NE = 64, EFF = 512, PLE = 256;
constexpr int IN_W = 9808;
constexpr int NIN_PAD = 9984;
constexpr float LN_EPS = 1e-5f;
constexpr float ALPHA = 1.189207115002721f;
constexpr int NWAVES = 8, NTHR = 512;

constexpr size_t MiB = 1u << 20;
constexpr size_t WS_CTL = 0, CTL_BYTES = 1 * MiB;
constexpr size_t WS_WIN = 1 * MiB;
constexpr size_t WS_WA = WS_WIN + 39 * MiB;
constexpr size_t WS_WB = WS_WA + 4 * MiB;
constexpr size_t WS_WO = WS_WB + 4 * MiB;
constexpr size_t WS_WPG = WS_WO + 8 * MiB;
constexpr size_t WS_WPE = WS_WPG + 8 * MiB;
constexpr size_t WS_RT = WS_WPE + 1 * MiB;
constexpr size_t WS_XB = WS_RT + 1 * MiB;
constexpr size_t WS_W1 = WS_XB + 32 * MiB;
constexpr size_t WS_Y = 1 * MiB;
constexpr size_t WS_W2 = WS_W1 + 260 * MiB;
static_assert(WS_Y + (size_t)90112 * 2048 * 2 <= WS_W2, "Y overlay");
constexpr size_t WS_Q = WS_W2 + 130 * MiB;
constexpr size_t WS_K = WS_Q + 16 * MiB;
constexpr size_t WS_V = WS_K + 4 * MiB;
constexpr size_t WS_QI = WS_V + 4 * MiB;
constexpr size_t WS_MISC = WS_QI + 16 * MiB;
constexpr size_t WS_WI = WS_MISC + 4 * MiB;
constexpr size_t WS_CB = WS_WI + 1 * MiB;
constexpr size_t WS_CC = WS_CB + 16 * MiB;
constexpr size_t WS_CH = WS_CC + 16 * MiB;
constexpr size_t WS_SA = WS_CH + 16 * MiB;
constexpr size_t WS_SB = WS_SA + 32 * MiB;
constexpr size_t WS_M1 = WS_SB + 32 * MiB;
constexpr size_t WS_H18 = WS_Q;
constexpr size_t WS_HID = WS_SA;
constexpr size_t WS_MG = WS_M1 + 32 * MiB;
constexpr size_t WS_PP = WS_MG + 32 * MiB;
constexpr size_t WS_PB = WS_PP + 32 * MiB;
constexpr size_t WS_YC = WS_PB + 4 * MiB;
constexpr size_t WS_SEL = WS_YC + 16 * MiB;
constexpr size_t WS_YA = WS_SEL + 8 * MiB;
constexpr size_t WS_PRE1 = WS_YA + 16 * MiB;
constexpr size_t WS_ACC2 = WS_PRE1;
constexpr size_t WS_H1F = WS_PRE1 + 64 * MiB;
constexpr size_t WS_H1B = WS_H1F + 64 * MiB;
constexpr size_t WS_TOKL = WS_H1B + 32 * MiB;
constexpr size_t WS_SLOT = WS_TOKL + 2 * MiB;
constexpr size_t WS_GATE = WS_SLOT + 1 * MiB;
constexpr size_t WS_END = WS_GATE + 1 * MiB;
static_assert(WS_END <= 1000 * MiB, "workspace map");

constexpr int CW_CNT = 64;
constexpr int CW_BAR = 4096;

constexpr int RING_BYTES = 131072;
constexpr int LDS_AUX = RING_BYTES;
constexpr int AUX_BYTES = 16384 + 1024;
constexpr int LDS_MISC = LDS_AUX + AUX_BYTES;
constexpr int LDS_BYTES = LDS_MISC + 256;

__device__ __forceinline__ unsigned f2bf(float f) { unsigned u = __builtin_bit_cast(unsigned, f); return (u + 0x7fffu + ((u >> 16) & 1u)) >> 16; }
__device__ __forceinline__ float bf2f(unsigned b) { return __builtin_bit_cast(float, b << 16); }
__device__ __forceinline__ float u2f(unsigned u) { return __builtin_bit_cast(float, u); }
__device__ __forceinline__ unsigned f2u(float f) { return __builtin_bit_cast(unsigned, f); }
__device__ __forceinline__ float bflo(unsigned w) { return __builtin_bit_cast(float, w << 16); }
__device__ __forceinline__ float bfhi(unsigned w) { return __builtin_bit_cast(float, w & 0xffff0000u); }
__device__ __forceinline__ unsigned cvt_pk_bf16(float lo, float hi) { unsigned r; asm volatile("v_cvt_pk_bf16_f32 %0, %1, %2" : "=v"(r) : "v"(lo), "v"(hi)); return r; }
__device__ __forceinline__ unsigned pk4_fp8(float a, float b, float c, float d) {
    int r = __builtin_amdgcn_cvt_pk_fp8_f32(a, b, 0, false); r = __builtin_amdgcn_cvt_pk_fp8_f32(c, d, r, true); return (unsigned)r; }
constexpr float W8_SCALE = 64.0f, W8_INV = 1.0f / 64.0f, Y8_SCALE = 16.0f, Y8_INV = 1.0f / 16.0f;
__device__ __forceinline__ float fast_sigmoid(float x) { return __builtin_amdgcn_rcpf(1.0f + __builtin_amdgcn_exp2f(-1.4426950408889634f * x)); }
#define LDS_WAIT() asm volatile("s_waitcnt lgkmcnt(0)" ::: "memory")
__device__ __forceinline__ unsigned lds_add(LAS unsigned* p, unsigned v) { return __hip_atomic_fetch_add(p, v, __ATOMIC_RELAXED, __HIP_MEMORY_SCOPE_WORKGROUP); }
__device__ __forceinline__ void lds_min(LAS unsigned* p, unsigned v) { (void)__hip_atomic_fetch_min(p, v, __ATOMIC_RELAXED, __HIP_MEMORY_SCOPE_WORKGROUP); }
__device__ __forceinline__ void lds_max(LAS unsigned* p, unsigned v) { (void)__hip_atomic_fetch_max(p, v, __ATOMIC_RELAXED, __HIP_MEMORY_SCOPE_WORKGROUP); }
__device__ __forceinline__ void lds_addf(LAS float* p, float v) { (void)__hip_atomic_fetch_add(p, v, __ATOMIC_RELAXED, __HIP_MEMORY_SCOPE_WORKGROUP); }
#define VM_WAIT() asm volatile("s_waitcnt vmcnt(0)" ::: "memory")

#define XB_TMO      128
#define XB_XCNT(j)  (256  + 64 * (j))
#define XB_XSUB(j)  (1280 + 64 * (j))
#define XB_XGEN(j)  (2304 + 64 * (j))
#define XB_TOP      3328
#define XB_TOPGEN   3392
#define XCD_BAR_WORDS 3456
#define XB_SPIN_CAP (1u << 18)
__device__ __forceinline__ unsigned xb_ld(unsigned* p)              { return __hip_atomic_load(p, __ATOMIC_RELAXED, __HIP_MEMORY_SCOPE_AGENT); }
__device__ __forceinline__ unsigned xb_add(unsigned* p, unsigned v) { return __hip_atomic_fetch_add(p, v, __ATOMIC_RELAXED, __HIP_MEMORY_SCOPE_AGENT); }
__device__ __forceinline__ unsigned xb_xcc_id() { return (unsigned)__builtin_amdgcn_s_getreg((3 << 11) | 20) & 0xFu; }
#define XB_SPIN(cond, bar) do { unsigned _sp = 0; while (cond) { __builtin_amdgcn_s_sleep(1); \
    if ((++_sp & 255u) == 0u) { if (xb_ld(&(bar)[XB_TMO])) break; if (_sp > XB_SPIN_CAP) { atomicAdd(&(bar)[XB_TMO], 1u); break; } } } } while (0)
struct XcdBarrier { unsigned* bar; unsigned x; volatile LAS unsigned* st; };
__device__ __forceinline__ XcdBarrier xcd_barrier_post(unsigned* bar, volatile LAS unsigned* st) {
    XcdBarrier b; b.bar = bar; b.x = xb_xcc_id(); b.st = st;
    if (threadIdx.x == 0) (void)xb_add(&bar[XB_XCNT(b.x)], 1u);
    return b;
}
__device__ __forceinline__ void xcd_barrier_complete(unsigned* bar, unsigned x, unsigned& nloc, unsigned& nx) {
    const unsigned G = gridDim.x * gridDim.y * gridDim.z;
    unsigned sum, cnt, mine, sp = 0u;
    for (;;) {
        sum = 0u; cnt = 0u; mine = 0u;
#pragma unroll
        for (unsigned j = 0; j < 16; ++j) { const unsigned c = xb_ld(&bar[XB_XCNT(j)]); sum += c; cnt += (c > 0u) ? 1u : 0u; mine = (j == x) ? c : mine; }
        if (sum == G) break;
        __builtin_amdgcn_s_sleep(1);
        if ((++sp & 255u) == 0u) { if (xb_ld(&bar[XB_TMO])) break; if (sp > XB_SPIN_CAP) { atomicAdd(&bar[XB_TMO], 1u); break; } }
    }
    nloc = mine > 0u ? mine : 1u; nx = cnt > 0u ? cnt : 1u;
}
__device__ __forceinline__ void xcd_barrier(const XcdBarrier& b) {
    asm volatile("s_waitcnt vmcnt(0)" ::: "memory");
    __syncthreads();
    if (threadIdx.x == 0) {
        unsigned* bar = b.bar;
        __builtin_amdgcn_s_waitcnt(0);
        unsigned nloc = b.st[0], nx = b.st[1];
        if (nloc == 0u) { xcd_barrier_complete(bar, b.x, nloc, nx); b.st[0] = nloc; b.st[1] = nx; }
        const unsigned old = xb_add(&bar[XB_XSUB(b.x)], 1u);
        const unsigned gen = old / nloc;
        if (old + 1u == (gen + 1u) * nloc) {
            __builtin_amdgcn_fence(__ATOMIC_RELEASE, "agent");
            asm volatile("s_waitcnt vmcnt(0)" ::: "memory");
            const unsigned og = xb_add(&bar[XB_TOP], 1u);
            const unsigned tg = og / nx;
            if (og + 1u == (tg + 1u) * nx) xb_add(&bar[XB_TOPGEN], 1u);
            else XB_SPIN(xb_ld(&bar[XB_TOPGEN]) == tg, bar);
            __builtin_amdgcn_fence(__ATOMIC_ACQUIRE, "agent");
            xb_add(&bar[XB_XGEN(b.x)], 1u);
            asm volatile("s_waitcnt vmcnt(0)" ::: "memory");
        } else {
            XB_SPIN(xb_ld(&bar[XB_XGEN(b.x)]) == gen, bar);
            __builtin_amdgcn_fence(__ATOMIC_ACQUIRE, "agent");
            asm volatile("s_waitcnt vmcnt(0)" ::: "memory");
        }
    }
    __syncthreads();
}

namespace pg8 {
constexpr int BM = 256, BK = 64, HALF = 128, HTB = HALF * BK * 2, STAGE_BYTES = 8 * HTB, NXCD = 8, WGM = 8;
__host__ __device__ __forceinline__ int lds_byte(int r, int c) { const int st = (r >> 4) * 2 + (c >> 5), rr = r & 15, cc = c & 31, ob = rr * 64 + cc * 2; return st * 1024 + (ob ^ (((ob >> 9) & 1) << 5)); }
__host__ __device__ __forceinline__ void stage_rc(int b, int& R, int& C) { const int st = b / 1024, sb = b % 1024, swz = sb ^ (((sb >> 9) & 1) << 5); R = (st >> 1) * 16 + swz / 64; C = (st & 1) * 32 + (swz % 64) / 2; }
__host__ __device__ __forceinline__ int perm32(int rho) { const int n = rho >> 4, i = rho & 15; return 8 * (i >> 2) + 4 * n + (i & 3); }

struct Unit { int pm, pn, e; };

struct DenseSched {
    const char* A; const char* Bt; int K; int rowb; int nM, nN, nwg, G, c;
    __device__ __forceinline__ void init(const void* A_, const void* Bt_, int M, int N, int K_, int G_, int c_) { A = (const char*)A_; Bt = (const char*)Bt_; K = K_; rowb = K_ * 2; nM = M / BM; nN = N / BM; nwg = nM * nN; G = G_; c = c_; }
    __device__ __forceinline__ bool next(int i, Unit& u) const {
        const long L = (long)i * G + c; if (L >= nwg) return false;
        int wgid = (int)L; { const int q = nwg / NXCD, r = nwg % NXCD, xcd = wgid % NXCD, off = wgid / NXCD; wgid = (xcd < r ? xcd * (q + 1) : r * (q + 1) + (xcd - r) * q) + off; }
        const int nig = WGM * nN, gid = wgid / nig, fm = gid * WGM, gsz = (nM - fm) < WGM ? (nM - fm) : WGM;
        u.pm = fm + ((wgid % nig) % gsz); u.pn = (wgid % nig) / gsz; u.e = 0; return true;
    }
    __device__ __forceinline__ const char* a_ptr(const Unit& u) const { return A + (size_t)u.pm * BM * rowb; }
    __device__ __forceinline__ const char* b_ptr(const Unit& u) const { return Bt + (size_t)u.pn * BM * rowb; }
    __device__ __forceinline__ void a_off(const Unit&, const int (&R)[2], const int (&C)[2], unsigned (&v)[2][2]) const {
#pragma unroll
        for (int h = 0; h < 2; ++h)
#pragma unroll
            for (int i = 0; i < 2; ++i) v[h][i] = (unsigned)((h * HALF + R[i]) * rowb + C[i] * 2);
    }
};

template <bool GATHER> struct MoeSched {
    const char* A; const char* Bt; size_t bstride; int K; int rowb; int npn; const LAS int* tstart; const int* cnt; const int* tokl; int total, G, c;
    __device__ __forceinline__ bool next(int i, Unit& u) const {
        const long L = (long)i * G + c; if (L >= total) return false;
        const int rt = (int)L / npn; u.pm = rt; u.pn = (int)L % npn;
        int lo = 0, hi = NE;
#pragma unroll
        for (int it = 0; it < 7; ++it) { const int mid = (lo + hi + 1) >> 1; if (tstart[mid] <= rt) lo = mid; else hi = mid - 1; }
        u.e = __builtin_amdgcn_readfirstlane(lo); u.pm = __builtin_amdgcn_readfirstlane(u.pm); u.pn = __builtin_amdgcn_readfirstlane(u.pn); return true;
    }
    __device__ __forceinline__ const char* a_ptr(const Unit& u) const { return GATHER ? A : A + (size_t)u.pm * BM * rowb; }
    __device__ __forceinline__ const char* b_ptr(const Unit& u) const { return Bt + (size_t)u.e * bstride + (size_t)u.pn * BM * rowb; }
    __device__ __forceinline__ void a_off(const Unit& u, const int (&R)[2], const int (&C)[2], unsigned (&v)[2][2]) const {
        if constexpr (GATHER) {
            const int base = (u.pm - tstart[u.e]) * BM; const int n = (u.e < NE) ? cnt[u.e] : T;
#pragma unroll
            for (int h = 0; h < 2; ++h)
#pragma unroll
                for (int i = 0; i < 2; ++i) { const int slot = base + h * HALF + R[i]; int tok = 0;
                    if (slot < n) tok = (u.e < NE) ? tokl[u.e * T + slot] : slot;
                    v[h][i] = (unsigned)(tok * rowb + C[i] * 2); }
        } else {
#pragma unroll
            for (int h = 0; h < 2; ++h)
#pragma unroll
                for (int i = 0; i < 2; ++i) v[h][i] = (unsigned)((h * HALF + R[i]) * rowb + C[i] * 2);
        }
    }
};

template <class Epi, class Sched, bool FP8 = false, int WSCALE = 0x7F7F7F7F>
__device__ __forceinline__ void gemm_phase(LAS unsigned char* lds, const Sched& S, const Epi& E) {
    const int tid = threadIdx.x, wid = __builtin_amdgcn_readfirstlane(tid >> 6), lane = tid & 63, wr = wid >> 2, wc = wid & 3, fr = lane & 15, fq = lane >> 4;
    const int rowb = S.rowb, nt = rowb / (BK * 2);
    int R[2], C[2]; unsigned voffB[2];
#pragma unroll
    for (int i = 0; i < 2; ++i) { stage_rc(tid * 16 + i * 8192, R[i], C[i]); const int Rb = Epi::PERM ? ((R[i] & ~31) + perm32(R[i] & 31)) : R[i]; voffB[i] = (unsigned)(Rb * rowb + C[i] * 2); }
    const size_t kstep = (size_t)(BK * 2);
    const size_t hstep = (size_t)HALF * rowb;
    const unsigned ldsw = (unsigned)wid * 1024u;
    const int aoff = lds_byte(wr * 64 + fr, fq * 8), boff = lds_byte(wc * 32 + fr, fq * 8);
#define PG8_SA(b, h) (((b) * 2 + (h)) * HTB)
#define PG8_SB(b, h) ((4 + (b) * 2 + (h)) * HTB)
#define PG8_STAGE(bufoff, gbase, voff) do { _Pragma("unroll") for (int _i = 0; _i < 2; ++_i) \
        __builtin_amdgcn_global_load_lds((const unsigned*)((const char*)(gbase) + (voff)[_i]), (LAS unsigned*)(lds + (bufoff) + ldsw + _i * 8192), 16, 0, 0); } while (0)
#define PG8_LDA(dst, b, h) do { if constexpr (FP8) { _Pragma("unroll") for (int m = 0; m < 4; ++m) { const i32x4 x0_ = *(const LAS i32x4*)(lds + PG8_SA(b, h) + aoff + m * 2048), x1_ = *(const LAS i32x4*)(lds + PG8_SA(b, h) + aoff + m * 2048 + 1024); \
            dst##8[m] = __builtin_shufflevector(x0_, x1_, 0, 1, 2, 3, 4, 5, 6, 7); } } \
        else { _Pragma("unroll") for (int m = 0; m < 4; ++m) _Pragma("unroll") for (int k = 0; k < 2; ++k) dst[m][k] = *(const LAS bf16x8*)(lds + PG8_SA(b, h) + aoff + m * 2048 + k * 1024); } } while (0)
#define PG8_LDB(dst, b, h) do { if constexpr (FP8) { _Pragma("unroll") for (int n = 0; n < 2; ++n) { const i32x4 x0_ = *(const LAS i32x4*)(lds + PG8_SB(b, h) + boff + n * 2048), x1_ = *(const LAS i32x4*)(lds + PG8_SB(b, h) + boff + n * 2048 + 1024); \
            dst##8[n] = __builtin_shufflevector(x0_, x1_, 0, 1, 2, 3, 4, 5, 6, 7); } } \
        else { _Pragma("unroll") for (int n = 0; n < 2; ++n) _Pragma("unroll") for (int k = 0; k < 2; ++k) dst[n][k] = *(const LAS bf16x8*)(lds + PG8_SB(b, h) + boff + n * 2048 + k * 1024); } } while (0)
#define PG8_MMA(ai, bj, At, Bt) do { __builtin_amdgcn_s_setprio(1); _Pragma("unroll") for (int m = 0; m < 4; ++m) _Pragma("unroll") for (int n = 0; n < 2; ++n) { \
        if constexpr (FP8)   \
            asm("v_mfma_scale_f32_16x16x128_f8f6f4 %0, %1, %2, %0, %3, %4 op_sel_hi:[0,0,0]" : "+v"(acc[ai][bj][m][n]) : "v"(Bt##8[n]), "v"(At##8[m]), "v"(w_e8m0), "v"(one_e8m0));   \
        else { _Pragma("unroll") for (int k = 0; k < 2; ++k) acc[ai][bj][m][n] = __builtin_amdgcn_mfma_f32_16x16x32_bf16(Bt[n][k], At[m][k], acc[ai][bj][m][n], 0, 0, 0); } } __builtin_amdgcn_s_setprio(0); } while (0)
#define PG8_WAIT_V(n) asm volatile("s_waitcnt vmcnt(" #n ")" ::: "memory")
#define PG8_WAIT_L(n) asm volatile("s_waitcnt lgkmcnt(" #n ")" ::: "memory")
#define PG8_BAR __builtin_amdgcn_s_barrier()
#define PG8_SCHED __builtin_amdgcn_sched_barrier(0)
    Unit cur, nxt; int ui = 0;
    if (!S.next(0, cur)) return;
    f32x4 acc[2][2][4][2];
#pragma unroll
    for (int a = 0; a < 2; ++a)
#pragma unroll
        for (int b = 0; b < 2; ++b)
#pragma unroll
            for (int m = 0; m < 4; ++m)
#pragma unroll
                for (int n = 0; n < 2; ++n) acc[a][b][m][n] = (f32x4){0.f, 0.f, 0.f, 0.f};
    bf16x8 At[4][2], B0[2][2], B1[2][2];
    i32x8 At8[4], B08[2], B18[2];
    const int one_e8m0 = 0x7F7F7F7F, w_e8m0 = WSCALE;
    unsigned cv[2][2], nv[2][2];
    S.a_off(cur, R, C, cv);
    const char* cA = S.a_ptr(cur); const char* cB = S.b_ptr(cur);
    PG8_STAGE(PG8_SB(0, 0), cB, voffB); PG8_STAGE(PG8_SB(0, 1), cB + hstep, voffB); PG8_STAGE(PG8_SA(0, 0), cA, cv[0]); PG8_STAGE(PG8_SA(0, 1), cA, cv[1]);
    if (wr == 1) PG8_BAR;
    PG8_WAIT_V(2); PG8_BAR;
    PG8_STAGE(PG8_SB(1, 0), cB + kstep, voffB); PG8_STAGE(PG8_SA(1, 0), cA + kstep, cv[0]); PG8_STAGE(PG8_SB(1, 1), cB + hstep + kstep, voffB);
    PG8_WAIT_V(6); PG8_BAR;
    for (;;) {
        const bool has_next = S.next(ui + 1, nxt);
        const char* nA = has_next ? S.a_ptr(nxt) : cA; const char* nB = has_next ? S.b_ptr(nxt) : cB;
        if (has_next) S.a_off(nxt, R, C, nv);
        else {
#pragma unroll
            for (int h = 0; h < 2; ++h)
#pragma unroll
                for (int i = 0; i < 2; ++i) nv[h][i] = cv[h][i]; }
        for (int t = 0; t < nt; t += 2) {
            const bool last = (t == nt - 2);
            const char* a1 = cA + (size_t)(t + 1) * kstep;
            const char* a2 = last ? nA : cA + (size_t)(t + 2) * kstep; const char* b2 = last ? nB : cB + (size_t)(t + 2) * kstep;
            const char* a3 = a2 + kstep; const char* b3 = b2 + kstep;
            unsigned v2[2][2];
#pragma unroll
            for (int h = 0; h < 2; ++h)
#pragma unroll
                for (int i = 0; i < 2; ++i) v2[h][i] = last ? nv[h][i] : cv[h][i];
            PG8_LDB(B0, 0, 0); PG8_LDB(B1, 0, 1); PG8_SCHED; PG8_LDA(At, 0, 0); PG8_STAGE(PG8_SA(1, 1), a1, cv[1]);
            PG8_WAIT_V(8); PG8_WAIT_L(0); PG8_BAR; PG8_MMA(0, 0, At, B0); PG8_MMA(0, 1, At, B1); PG8_BAR; PG8_SCHED;
            PG8_LDA(At, 0, 1); PG8_STAGE(PG8_SB(0, 0), b2, voffB); PG8_STAGE(PG8_SB(0, 1), b2 + hstep, voffB); PG8_STAGE(PG8_SA(0, 0), a2, v2[0]);
            PG8_WAIT_V(8); PG8_WAIT_L(0); PG8_BAR; PG8_MMA(1, 0, At, B0); PG8_MMA(1, 1, At, B1); PG8_BAR; PG8_SCHED;
            PG8_LDB(B0, 1, 0); PG8_LDB(B1, 1, 1); PG8_SCHED; PG8_LDA(At, 1, 0); PG8_STAGE(PG8_SA(0, 1), a2, v2[1]);
            PG8_WAIT_V(8); PG8_WAIT_L(0); PG8_BAR; PG8_MMA(0, 0, At, B0); PG8_MMA(0, 1, At, B1); PG8_BAR; PG8_SCHED;
            PG8_LDA(At, 1, 1); PG8_STAGE(PG8_SB(1, 0), b3, voffB); PG8_STAGE(PG8_SB(1, 1), b3 + hstep, voffB); PG8_STAGE(PG8_SA(1, 0), a3, v2[0]);
            PG8_WAIT_V(8); PG8_WAIT_L(0); PG8_BAR; PG8_MMA(1, 0, At, B0); PG8_MMA(1, 1, At, B1); PG8_BAR; PG8_SCHED;
        }
        if constexpr (FP8) asm volatile("s_nop 15\n\ts_nop 15" ::: "memory");
        if (wr == 0) PG8_BAR;
        E(acc, cur, wr, wc, fr, fq);
        if (!has_next) break;
#pragma unroll
        for (int a = 0; a < 2; ++a)
#pragma unroll
            for (int b = 0; b < 2; ++b)
#pragma unroll
                for (int m = 0; m < 4; ++m)
#pragma unroll
                    for (int n = 0; n < 2; ++n) acc[a][b][m][n] = (f32x4){0.f, 0.f, 0.f, 0.f};
        cur = nxt; cA = nA; cB = nB; ++ui;
#pragma unroll
        for (int h = 0; h < 2; ++h)
#pragma unroll
            for (int i = 0; i < 2; ++i) cv[h][i] = nv[h][i];
        if (wr == 1) PG8_BAR;
    }
    PG8_WAIT_V(0);
    PG8_BAR;
#undef PG8_SA
#undef PG8_SB
#undef PG8_STAGE
#undef PG8_LDA
#undef PG8_LDB
#undef PG8_MMA
#undef PG8_WAIT_V
#undef PG8_WAIT_L
#undef PG8_BAR
#undef PG8_SCHED
}
}
using pg8::Unit;

typedef const f32x4 (&AccRef)[2][2][4][2];

template <int ACT> __device__ __forceinline__ void store_tile_bf16(AccRef acc, bf16_t* O, int ld, size_t row0, int col0, int wr, int wc, int fr, int fq) {
#pragma unroll
    for (int ai = 0; ai < 2; ++ai)
#pragma unroll
        for (int m = 0; m < 4; ++m) { bf16_t* rowp = O + (row0 + ai * 128 + wr * 64 + m * 16 + fr) * (size_t)ld + col0 + wc * 32 + 8 * fq;
#pragma unroll
            for (int bj = 0; bj < 2; ++bj) { f32x4 v0 = acc[ai][bj][m][0], v1 = acc[ai][bj][m][1];
                if (ACT == 1) {
#pragma unroll
                    for (int j = 0; j < 4; ++j) { v0[j] = fast_sigmoid(v0[j]); v1[j] = fast_sigmoid(v1[j]); } }
                u32x4 w; w.x = cvt_pk_bf16(v0[0], v0[1]); w.y = cvt_pk_bf16(v0[2], v0[3]); w.z = cvt_pk_bf16(v1[0], v1[1]); w.w = cvt_pk_bf16(v1[2], v1[3]);
                *(u32x4*)(rowp + bj * 128) = w; } }
}

struct EpiInProj {
    static constexpr bool PERM = true;
    unsigned char* ws;
    __device__ __forceinline__ void operator()(AccRef acc, const Unit& u, int wr, int wc, int fr, int fq) const {
        const int pn = u.pn; const size_t row0 = (size_t)u.pm * 256;
        size_t boff; int ld, col0; bool sig = false;
        if (pn < 4) { boff = WS_Q; ld = AW; col0 = pn * 256; }
        else if (pn == 4) { boff = WS_K; ld = 256; col0 = 0; }
        else if (pn == 5) { boff = WS_V; ld = 256; col0 = 0; }
        else if (pn < 10) { boff = WS_QI; ld = 1024; col0 = (pn - 6) * 256; }
        else if (pn == 10) { boff = WS_MISC; ld = 256; col0 = 0; }
        else if (pn < 15) { boff = WS_CB; ld = CW; col0 = (pn - 11) * 256; }
        else if (pn < 19) { boff = WS_CC; ld = CW; col0 = (pn - 15) * 256; }
        else if (pn < 23) { boff = WS_CH; ld = CW; col0 = (pn - 19) * 256; }
        else if (pn < 31) { boff = WS_SA; ld = D; col0 = (pn - 23) * 256; sig = true; }
        else { boff = WS_SB; ld = D; col0 = (pn - 31) * 256; sig = true; }
        if (pn == 10) {
            if (wc < 2) { bf16_t* KIo = (bf16_t*)(ws + WS_MISC);
#pragma unroll
                for (int ai = 0; ai < 2; ++ai)
#pragma unroll
                    for (int m = 0; m < 4; ++m) { const f32x4 v0 = acc[ai][0][m][0], v1 = acc[ai][0][m][1];
                        u32x4 w; w.x = cvt_pk_bf16(v0[0], v0[1]); w.y = cvt_pk_bf16(v0[2], v0[3]); w.z = cvt_pk_bf16(v1[0], v1[1]); w.w = cvt_pk_bf16(v1[2], v1[3]);
                        const size_t key = row0 + ai * 128 + wr * 64 + m * 16 + fr;
                        *(u32x4*)(KIo + (((key >> 4) * 2 + wc) * 64 + fr + 16 * fq) * 8) = w; } }
        }
        else if (sig) store_tile_bf16<1>(acc, (bf16_t*)(ws + boff), ld, row0, col0, wr, wc, fr, fq);
        else store_tile_bf16<0>(acc, (bf16_t*)(ws + boff), ld, row0, col0, wr, wc, fr, fq);
        if (pn == 10 && wc == 2 && fq < 2) {
            float* WI = (float*)(ws + WS_WI);
#pragma unroll
            for (int ai = 0; ai < 2; ++ai)
#pragma unroll
                for (int m = 0; m < 4; ++m) { float* rp = WI + (row0 + ai * 128 + wr * 64 + m * 16 + fr) * 16 + 8 * fq;
                    *(f32x4*)(rp) = acc[ai][0][m][0] * 0.03125f; *(f32x4*)(rp + 4) = acc[ai][0][m][1] * 0.03125f; }
        }
    }
};
struct EpiPlain {
    static constexpr bool PERM = true;
    bf16_t* O; int ld;
    __device__ __forceinline__ void operator()(AccRef acc, const Unit& u, int wr, int wc, int fr, int fq) const {
        store_tile_bf16<0>(acc, O, ld, (size_t)u.pm * 256, u.pn * 256, wr, wc, fr, fq);
    }
};
struct EpiY8 {
    static constexpr bool PERM = true;
    unsigned char* O; float sc;
    __device__ __forceinline__ void operator()(AccRef acc, const Unit& u, int wr, int wc, int fr, int fq) const {
#pragma unroll
        for (int ai = 0; ai < 2; ++ai)
#pragma unroll
            for (int m = 0; m < 4; ++m) { unsigned char* rowp = O + ((size_t)u.pm * 256 + ai * 128 + wr * 64 + m * 16 + fr) * (size_t)D + u.pn * 256 + wc * 32 + 8 * fq;
#pragma unroll
                for (int bj = 0; bj < 2; ++bj) { const f32x4 v0 = acc[ai][bj][m][0] * sc, v1 = acc[ai][bj][m][1] * sc;
                    u32x2 w; w.x = pk4_fp8(v0[0], v0[1], v0[2], v0[3]); w.y = pk4_fp8(v1[0], v1[1], v1[2], v1[3]);
                    *(u32x2*)(rowp + bj * 128) = w; } }
    }
};
template <bool ADD> struct EpiGate {
    static constexpr bool PERM = true;
    const bf16_t* G; const bf16_t* P; bf16_t* O;
    __device__ __forceinline__ void operator()(AccRef acc, const Unit& u, int wr, int wc, int fr, int fq) const {
#pragma unroll
        for (int ai = 0; ai < 2; ++ai)
#pragma unroll
            for (int m = 0; m < 4; ++m) { const size_t off = ((size_t)u.pm * 256 + ai * 128 + wr * 64 + m * 16 + fr) * D + u.pn * 256 + wc * 32 + 8 * fq;
#pragma unroll
                for (int bj = 0; bj < 2; ++bj) { f32x4 v0 = acc[ai][bj][m][0], v1 = acc[ai][bj][m][1];
                    const u32x4 g = *(const u32x4*)(G + off + bj * 128);
                    v0[0] *= bflo(g.x); v0[1] *= bfhi(g.x); v0[2] *= bflo(g.y); v0[3] *= bfhi(g.y); v1[0] *= bflo(g.z); v1[1] *= bfhi(g.z); v1[2] *= bflo(g.w); v1[3] *= bfhi(g.w);
                    if (ADD) { const u32x4 p = *(const u32x4*)(P + off + bj * 128);
                        v0[0] += bflo(p.x); v0[1] += bfhi(p.x); v0[2] += bflo(p.y); v0[3] += bfhi(p.y); v1[0] += bflo(p.z); v1[1] += bfhi(p.z); v1[2] += bflo(p.w); v1[3] += bfhi(p.w); }
                    u32x4 w; w.x = cvt_pk_bf16(v0[0], v0[1]); w.y = cvt_pk_bf16(v0[2], v0[3]); w.z = cvt_pk_bf16(v1[0], v1[1]); w.w = cvt_pk_bf16(v1[2], v1[3]);
                    *(u32x4*)(O + off + bj * 128) = w; } }
    }
};
struct EpiResid {
    static constexpr bool PERM = false;
    const float* X; bf16_t* O;
    __device__ __forceinline__ void operator()(AccRef acc, const Unit& u, int wr, int wc, int fr, int fq) const {
#pragma unroll
        for (int ai = 0; ai < 2; ++ai)
#pragma unroll
            for (int m = 0; m < 4; ++m) { const size_t off = ((size_t)u.pm * 256 + ai * 128 + wr * 64 + m * 16 + fr) * D + u.pn * 256 + wc * 32 + 4 * fq;
#pragma unroll
                for (int bj = 0; bj < 2; ++bj)
#pragma unroll
                    for (int n = 0; n < 2; ++n) { const f32x4 x = *(const f32x4*)(X + off + bj * 128 + n * 16); const f32x4 r = x * ALPHA + acc[ai][bj][m][n];
                        u32x2 w; w.x = cvt_pk_bf16(r[0], r[1]); w.y = cvt_pk_bf16(r[2], r[3]); *(u32x2*)(O + off + bj * 128 + n * 16) = w; } }
    }
};
struct EpiPle {
    static constexpr bool PERM = false;
    const bf16_t* H; const bf16_t* PP; bf16_t* O;
    __device__ __forceinline__ void operator()(AccRef acc, const Unit& u, int wr, int wc, int fr, int fq) const {
#pragma unroll
        for (int ai = 0; ai < 2; ++ai)
#pragma unroll
            for (int m = 0; m < 4; ++m) { const size_t off = ((size_t)u.pm * 256 + ai * 128 + wr * 64 + m * 16 + fr) * D + u.pn * 256 + wc * 32 + 4 * fq;
#pragma unroll
                for (int bj = 0; bj < 2; ++bj)
#pragma unroll
                    for (int n = 0; n < 2; ++n) { const size_t o = off + bj * 128 + n * 16; const u32x2 h = *(const u32x2*)(H + o); const u32x2 p = *(const u32x2*)(PP + o);
                        const f32x4 a = acc[ai][bj][m][n]; f32x4 r;
                        r[0] = bflo(h.x) * ALPHA + fast_sigmoid(a[0] * W8_INV) * bflo(p.x); r[1] = bfhi(h.x) * ALPHA + fast_sigmoid(a[1] * W8_INV) * bfhi(p.x);
                        r[2] = bflo(h.y) * ALPHA + fast_sigmoid(a[2] * W8_INV) * bflo(p.y); r[3] = bfhi(h.y) * ALPHA + fast_sigmoid(a[3] * W8_INV) * bfhi(p.y);
                        u32x2 w; w.x = cvt_pk_bf16(r[0], r[1]); w.y = cvt_pk_bf16(r[2], r[3]); *(u32x2*)(O + o) = w; } }
    }
};
struct EpiSwiGlu {
    static constexpr bool PERM = true;
    unsigned char* HID;
    __device__ __forceinline__ void operator()(AccRef acc, const Unit& u, int wr, int wc, int fr, int fq) const {
#pragma unroll
        for (int ai = 0; ai < 2; ++ai)
#pragma unroll
            for (int m = 0; m < 4; ++m) { unsigned char* rowp = HID + ((size_t)u.pm * 256 + ai * 128 + wr * 64 + m * 16 + fr) * EFF + u.pn * 128 + wc * 32 + 8 * fq;
                f32x4 h0, h1;
#pragma unroll
                for (int j = 0; j < 4; ++j) { const float g0 = acc[ai][0][m][0][j] * W8_INV, g1 = acc[ai][0][m][1][j] * W8_INV;
                    h0[j] = g0 * fast_sigmoid(g0) * (acc[ai][1][m][0][j] * W8_INV); h1[j] = g1 * fast_sigmoid(g1) * (acc[ai][1][m][1][j] * W8_INV); }
                u32x2 w; w.x = pk4_fp8(h0[0], h0[1], h0[2], h0[3]); w.y = pk4_fp8(h1[0], h1[1], h1[2], h1[3]);
                *(u32x2*)rowp = w; }
    }
};

struct Args { const float* in[21]; float* out; unsigned char* ws; int ph_lo, ph_hi; };

__device__ __forceinline__ const float* karg(int i) { const float* p = ((const float* const*)__builtin_amdgcn_kernarg_segment_ptr())[i]; asm volatile("" : "+s"(p)); return p; }
struct Frame {
    LAS unsigned char* lds; int tid, lane, wave, G, vcu, gw, NGW;
    unsigned char* ws;
};

__device__ __forceinline__ void transpose_item(const float* src, int ldsrc, bf16_t* dst, int K, int nvalid, LAS float* scr, int lane) {
    if (nvalid > 0) {
#pragma unroll 8
        for (int i = 0; i < 32; ++i) { const int kk = 2 * i + (lane >> 5), n = lane & 31; scr[kk * 33 + n] = (n < nvalid) ? src[(size_t)kk * ldsrc + n] : 0.f; }
    } else {
#pragma unroll 8
        for (int i = 0; i < 32; ++i) { const int kk = 2 * i + (lane >> 5), n = lane & 31; scr[kk * 33 + n] = 0.f; }
    }
    LDS_WAIT(); asm volatile("" ::: "memory");
    const int c = lane & 7;
#pragma unroll
    for (int j = 0; j < 4; ++j) { const int n = (lane >> 3) + 8 * j; const LAS float* s = scr + (8 * c) * 33 + n;
        u32x4 o; o.x = cvt_pk_bf16(s[0 * 33], s[1 * 33]); o.y = cvt_pk_bf16(s[2 * 33], s[3 * 33]); o.z = cvt_pk_bf16(s[4 * 33], s[5 * 33]); o.w = cvt_pk_bf16(s[6 * 33], s[7 * 33]);
        *(u32x4*)(dst + (size_t)n * K + 8 * c) = o; }
    LDS_WAIT(); asm volatile("" ::: "memory");
}
__device__ __forceinline__ void router_item(const float* src, bf16_t* hi, bf16_t* lo, int k0, int n0, LAS float* scr, int lane) {
#pragma unroll 8
    for (int i = 0; i < 32; ++i) { const int kk = 2 * i + (lane >> 5), n = lane & 31; scr[kk * 33 + n] = src[(size_t)(k0 + kk) * NE + n0 + n]; }
    LDS_WAIT(); asm volatile("" ::: "memory");
    const int c = lane & 7;
#pragma unroll
    for (int j = 0; j < 4; ++j) { const int n = (lane >> 3) + 8 * j; const LAS float* s = scr + (8 * c) * 33 + n;
        float w[8], r[8]; unsigned h[8];
#pragma unroll
        for (int q = 0; q < 8; ++q) { w[q] = s[q * 33]; h[q] = f2bf(w[q]); r[q] = w[q] - bf2f(h[q]); }
        u32x4 oh, ol; oh.x = h[0] | (h[1] << 16); oh.y = h[2] | (h[3] << 16); oh.z = h[4] | (h[5] << 16); oh.w = h[6] | (h[7] << 16);
        ol.x = cvt_pk_bf16(r[0], r[1]); ol.y = cvt_pk_bf16(r[2], r[3]); ol.z = cvt_pk_bf16(r[4], r[5]); ol.w = cvt_pk_bf16(r[6], r[7]);
        *(u32x4*)(hi + (size_t)(n0 + n) * D + k0 + 8 * c) = oh; *(u32x4*)(lo + (size_t)(n0 + n) * D + k0 + 8 * c) = ol; }
    LDS_WAIT(); asm volatile("" ::: "memory");
}

struct CvtItem { const float* src; bf16_t* dst; int ldsrc, K, nvalid, fp8; };
__device__ __forceinline__ void cvt_load(const CvtItem& d, f32x4 (&r)[8], int lane) {
    const int nq = lane & 7, kq = lane >> 3;
    const float* p = d.src + (size_t)(8 * kq) * d.ldsrc + 4 * nq;
    const int nv = d.nvalid - 4 * nq;
#pragma unroll
    for (int i = 0; i < 8; ++i) { f32x4 v = (f32x4){0.f, 0.f, 0.f, 0.f}; if (nv >= 4) v = __builtin_nontemporal_load((const f32x4*)(p + (size_t)i * d.ldsrc)); r[i] = v; }
}
__device__ __forceinline__ void cvt_store(const CvtItem& d, const f32x4 (&r)[8], int lane) {
    const int nq = lane & 7, kq = lane >> 3;
    if (d.fp8) { unsigned char* o8 = (unsigned char*)d.dst + (size_t)(4 * nq) * d.K + 8 * kq; const float ws8 = d.fp8 == 2 ? 4.0f : W8_SCALE;
#pragma unroll
        for (int c = 0; c < 4; ++c) { u32x2 w; w.x = pk4_fp8(r[0][c] * ws8, r[1][c] * ws8, r[2][c] * ws8, r[3][c] * ws8); w.y = pk4_fp8(r[4][c] * ws8, r[5][c] * ws8, r[6][c] * ws8, r[7][c] * ws8);
            __builtin_nontemporal_store(w, (u32x2*)(o8 + (size_t)c * d.K)); }
        return; }
    bf16_t* o = d.dst + (size_t)(4 * nq) * d.K + 8 * kq;
#pragma unroll
    for (int c = 0; c < 4; ++c) { u32x4 w; w.x = cvt_pk_bf16(r[0][c], r[1][c]); w.y = cvt_pk_bf16(r[2][c], r[3][c]); w.z = cvt_pk_bf16(r[4][c], r[5][c]); w.w = cvt_pk_bf16(r[6][c], r[7][c]);
        __builtin_nontemporal_store(w, (u32x4*)(o + (size_t)c * d.K)); }
}
constexpr int CV_I_IN = (NIN_PAD / 32) * (D / 64), CV_I_A = (D / 32) * (AW / 64), CV_I_O = (D / 32) * (D / 64), CV_I_PE = (D / 32) * (PLE / 64);
constexpr int CV_I_W1E = (1024 / 32) * (D / 64), CV_I_W2E = (D / 32) * (EFF / 64), CV_I_RT = (NE / 32) * (D / 64);
constexpr int CV_N0 = CV_I_IN, CV_N1 = CV_N0 + CV_I_A, CV_N2 = CV_N1 + CV_I_A, CV_N3 = CV_N2 + CV_I_O, CV_N4 = CV_N3 + CV_I_O, CV_N5 = CV_N4 + CV_I_PE, CV_N6 = CV_N5 + 65 * CV_I_W1E, CV_N7 = CV_N6 + 65 * CV_I_W2E;
__device__ __forceinline__ CvtItem cvt_desc(const Args& a, unsigned char* ws, int it) {
    CvtItem d; d.nvalid = 32; d.fp8 = 0;
    if (it < CV_N0) {
        const int db = it / (D / 64), kb = it % (D / 64); int sc;
        if (db < 80) sc = 32 * db; else if (db < 88) { sc = 2560 + 32 * (db - 80); int nv = 80 - 32 * (db - 80); d.nvalid = nv < 0 ? 0 : (nv > 32 ? 32 : nv); if (d.nvalid == 0) sc = 2560; } else sc = 2640 + 32 * (db - 88);
        d.src = karg(2) + (size_t)(64 * kb) * IN_W + sc; d.ldsrc = IN_W; d.dst = (bf16_t*)(ws + WS_WIN) + (size_t)(32 * db) * D + 64 * kb; d.K = D;
    } else if (it < CV_N2) {
        const bool second = it >= CV_N1; const int r = it - (second ? CV_N1 : CV_N0); const int db = r / (AW / 64), kb = r % (AW / 64);
        d.src = karg(second ? 5 : 4) + (size_t)(64 * kb) * D + 32 * db; d.ldsrc = D; d.K = AW;
        if (!second) { d.dst = (bf16_t*)(ws + WS_WA + (size_t)(32 * db) * AW + 64 * kb); d.fp8 = 2; }
        else d.dst = (bf16_t*)(ws + WS_WB) + (size_t)(32 * db) * AW + 64 * kb;
    } else if (it < CV_N4) {
        const bool second = it >= CV_N3; const int r = it - (second ? CV_N3 : CV_N2); const int db = r / (D / 64), kb = r % (D / 64);
        d.src = karg(second ? 17 : 6) + (size_t)(64 * kb) * D + 32 * db; d.ldsrc = D; d.K = D;
        if (second) { d.dst = (bf16_t*)(ws + WS_WPG + (size_t)(32 * db) * D + 64 * kb); d.fp8 = 1; }
        else d.dst = (bf16_t*)(ws + WS_WO) + (size_t)(32 * db) * D + 64 * kb;
    } else if (it < CV_N5) {
        const int r = it - CV_N4; const int db = r / (PLE / 64), kb = r % (PLE / 64);
        d.src = karg(18) + (size_t)(64 * kb) * D + 32 * db; d.ldsrc = D; d.dst = (bf16_t*)(ws + WS_WPE) + (size_t)(32 * db) * PLE + 64 * kb; d.K = PLE;
    } else if (it < CV_N6) {
        const int r = it - CV_N5; const int e = r / CV_I_W1E, q = r % CV_I_W1E; const int db = q / (D / 64), kb = q % (D / 64);
        const int ntile = db >> 3, within = (db & 7) * 32; const bool up = within >= 128; const int col = ntile * 128 + (up ? within - 128 : within);
        const float* src = (e < NE) ? (karg(up ? 12 : 11) + (size_t)e * D * EFF) : karg(up ? 15 : 14);
        d.src = src + (size_t)(64 * kb) * EFF + col; d.ldsrc = EFF; d.dst = (bf16_t*)(ws + WS_W1 + ((size_t)e * 1024 + 32 * db) * D + 64 * kb); d.K = D; d.fp8 = 1;
    } else {
        const int r = it - CV_N6; const int e = r / CV_I_W2E, q = r % CV_I_W2E; const int db = q / (EFF / 64), kb = q % (EFF / 64);
        const float* src = (e < NE) ? (karg(13) + (size_t)e * EFF * D) : karg(16);
        d.src = src + (size_t)(64 * kb) * D + 32 * db; d.ldsrc = D; d.dst = (bf16_t*)(ws + WS_W2 + ((size_t)e * D + 32 * db) * EFF + 64 * kb); d.K = EFF; d.fp8 = 1;
    }
    return d;
}
#ifndef NCONV
#define NCONV 48
#endif
#ifndef CONV_SHARE
#define CONV_SHARE 60
#endif
#ifndef CONV_FRAC_P2
#define CONV_FRAC_P2 70
#endif
constexpr int CV_P0_END = (NCONV > 0) ? CV_N5 + (int)((long)(CV_N7 - CV_N5) * (100 - CONV_SHARE) / 100) : CV_N7;
constexpr int CV_SPLIT = CV_P0_END + (int)((long)(CV_N7 - CV_P0_END) * CONV_FRAC_P2 / 100);
__device__ __forceinline__ void convert_range(const Args& a, unsigned char* ws, int i0, int i1, int cw, int ncw, int lane) {
    f32x4 r0[8], r1[8], r2[8], r3[8];
    CvtItem d0, d1, d2, d3;
    int it = i0 + cw;
    if (it >= i1) return;
    const int last = i1 - 1;
#define CV_LD(d, r, k) do { int j_ = it + (k) * ncw; d = cvt_desc(a, ws, j_ < i1 ? j_ : last); cvt_load(d, r, lane); } while (0)
    CV_LD(d0, r0, 0); CV_LD(d1, r1, 1); CV_LD(d2, r2, 2); CV_LD(d3, r3, 3);
#pragma unroll 1
    for (;;) {
        __builtin_amdgcn_sched_barrier(0);
        cvt_store(d0, r0, lane); it += ncw; if (it >= i1) break;
        __builtin_amdgcn_sched_barrier(0);
        CV_LD(d0, r0, 3);
        __builtin_amdgcn_sched_barrier(0);
        cvt_store(d1, r1, lane); it += ncw; if (it >= i1) break;
        __builtin_amdgcn_sched_barrier(0);
        CV_LD(d1, r1, 3);
        __builtin_amdgcn_sched_barrier(0);
        cvt_store(d2, r2, lane); it += ncw; if (it >= i1) break;
        __builtin_amdgcn_sched_barrier(0);
        CV_LD(d2, r2, 3);
        __builtin_amdgcn_sched_barrier(0);
        cvt_store(d3, r3, lane); it += ncw; if (it >= i1) break;
        __builtin_amdgcn_sched_barrier(0);
        CV_LD(d3, r3, 3);
    }
#undef CV_LD
}

__device__ __forceinline__ void phase_convert(const Frame& F, const Args& a) {
    LAS float* scr = (LAS float*)(F.lds + F.wave * 16384);
    unsigned char* ws = F.ws;
    convert_range(a, ws, 0, CV_P0_END, F.gw, F.NGW, F.lane);
    for (int r = F.gw; r < CV_I_RT; r += F.NGW) { const int db = r / (D / 64), kb = r % (D / 64);
        router_item(karg(9), (bf16_t*)(ws + WS_RT), (bf16_t*)(ws + WS_RT) + (size_t)NE * D, 64 * kb, 32 * db, scr, F.lane); }
    { const float* x = karg(0); bf16_t* xb = (bf16_t*)(ws + WS_XB); const size_t n8 = (size_t)T * D / 8;
      for (size_t i = (size_t)blockIdx.x * NTHR + F.tid; i < n8; i += (size_t)F.G * NTHR) { const f32x4 v0 = *(const f32x4*)(x + i * 8), v1 = *(const f32x4*)(x + i * 8 + 4);
          u32x4 w; w.x = cvt_pk_bf16(v0[0], v0[1]); w.y = cvt_pk_bf16(v0[2], v0[3]); w.z = cvt_pk_bf16(v1[0], v1[1]); w.w = cvt_pk_bf16(v1[2], v1[3]); *(u32x4*)(xb + i * 8) = w; } }
    { const float* p = karg(1); bf16_t* pb = (bf16_t*)(ws + WS_PB); const size_t n8 = (size_t)T * PLE / 8;
      for (size_t i = (size_t)blockIdx.x * NTHR + F.tid; i < n8; i += (size_t)F.G * NTHR) { const f32x4 v0 = *(const f32x4*)(p + i * 8), v1 = *(const f32x4*)(p + i * 8 + 4);
          u32x4 w; w.x = cvt_pk_bf16(v0[0], v0[1]); w.y = cvt_pk_bf16(v0[2], v0[3]); w.z = cvt_pk_bf16(v1[0], v1[1]); w.w = cvt_pk_bf16(v1[2], v1[3]); *(u32x4*)(pb + i * 8) = w; } }
}

#define DPP_XADD(v, ctrl) ((v) + u2f((unsigned)__builtin_amdgcn_update_dpp(0, (int)f2u(v), (ctrl), 0xF, 0xF, true)))
__device__ __forceinline__ float wave_sum(float v) {
    v = DPP_XADD(v, 0xB1);
    v = DPP_XADD(v, 0x4E);
    v = DPP_XADD(v, 0x141);
    v = DPP_XADD(v, 0x140);
    { const auto r = __builtin_amdgcn_permlane16_swap(f2u(v), f2u(v), false, false); const unsigned a = r[0], b = r[1]; v = u2f(a) + u2f(b); }
    { const auto r = __builtin_amdgcn_permlane32_swap(f2u(v), f2u(v), false, false); const unsigned a = r[0], b = r[1]; v = u2f(a) + u2f(b); }
    return v;
}

__device__ __forceinline__ void phase_yconv(const Frame& F, const float* conv_w, int wb, int wG) {
    const bf16_t* CB = (const bf16_t*)(F.ws + WS_CB); const bf16_t* CC = (const bf16_t*)(F.ws + WS_CC); const bf16_t* CH = (const bf16_t*)(F.ws + WS_CH); bf16_t* YC = (bf16_t*)(F.ws + WS_YC);
    const int total = T * (CW / 8);
    for (int idx = wb * NTHR + F.tid; idx < total; idx += wG * NTHR) {
        const int t = idx / (CW / 8), c = (idx % (CW / 8)) * 8;
        float accv[8];
#pragma unroll
        for (int j = 0; j < 8; ++j) accv[j] = 0.f;
#pragma unroll
        for (int d = 0; d < 3; ++d) { const int tt = t - 2 + d;
            if (tt >= 0) { const u32x4 cc = *(const u32x4*)(CC + (size_t)tt * CW + c), ch = *(const u32x4*)(CH + (size_t)tt * CW + c);
                const f32x4 w0 = *(const f32x4*)(conv_w + d * CW + c), w1 = *(const f32x4*)(conv_w + d * CW + c + 4);
                accv[0] += w0[0] * (bflo(cc.x) * bflo(ch.x)); accv[1] += w0[1] * (bfhi(cc.x) * bfhi(ch.x)); accv[2] += w0[2] * (bflo(cc.y) * bflo(ch.y)); accv[3] += w0[3] * (bfhi(cc.y) * bfhi(ch.y));
                accv[4] += w1[0] * (bflo(cc.z) * bflo(ch.z)); accv[5] += w1[1] * (bfhi(cc.z) * bfhi(ch.z)); accv[6] += w1[2] * (bflo(cc.w) * bflo(ch.w)); accv[7] += w1[3] * (bfhi(cc.w) * bfhi(ch.w)); } }
        const u32x4 cb = *(const u32x4*)(CB + (size_t)t * CW + c);
        u32x4 o; o.x = cvt_pk_bf16(accv[0] * bflo(cb.x), accv[1] * bfhi(cb.x)); o.y = cvt_pk_bf16(accv[2] * bflo(cb.y), accv[3] * bfhi(cb.y));
        o.z = cvt_pk_bf16(accv[4] * bflo(cb.z), accv[5] * bfhi(cb.z)); o.w = cvt_pk_bf16(accv[6] * bflo(cb.w), accv[7] * bfhi(cb.w));
        *(u32x4*)(YC + (size_t)t * CW + c) = o;
    }
}

__device__ __forceinline__ unsigned f2key(float f) { const unsigned u = __builtin_bit_cast(unsigned, f); return (u & 0x80000000u) ? ~u : (u | 0x80000000u); }
__device__ __forceinline__ float key2f(unsigned k) { const unsigned u = (k & 0x80000000u) ? (k & 0x7fffffffu) : ~k; return __builtin_bit_cast(float, u); }
constexpr int NBIN = 1024, CAND_CAP = 128;
struct RowState { unsigned kmin, kmax; float flo, scale; int bstar, cabove, cstar, need; unsigned ncand, nout, cmin, cmax; int done, level; unsigned cmin0, cmax0; };

__device__ __forceinline__ void phase_indexer(const Frame& F, int wb, int wG) {
    const bf16_t* QI = (const bf16_t*)(F.ws + WS_QI); const bf16_t* KI = (const bf16_t*)(F.ws + WS_MISC); const float* WI = (const float*)(F.ws + WS_WI); int* SEL = (int*)(F.ws + WS_SEL);
    LAS float* sc = (LAS float*)F.lds;
    LAS unsigned* hist = (LAS unsigned*)(F.lds + LDS_AUX);
    LAS RowState* rs = (LAS RowState*)(F.lds + LDS_AUX + 16384);
    const int lane = F.lane, wave = F.wave, fr = lane & 15, fq = lane >> 4;
    constexpr int NGRP = T / 4;
    for (int gi = wb; gi < NGRP + wG; gi += wG) {
        const int rnd = gi / wG, cidx = gi % wG; const int g = (rnd & 1) ? (rnd * wG + (wG - 1 - cidx)) : gi;
        if (g >= NGRP) continue;
        const int t0 = g * 4;
        if (t0 < 256) {
            for (int q = 0; q < 4; ++q) { const int t = t0 + q; for (int i = F.tid; i <= t; i += NTHR) SEL[(size_t)t * TOPK + i] = i; }
            continue;
        }
#ifdef PROBE_SEL_RECENT
        { for (int q = 0; q < 4; ++q) { const int t = t0 + q; for (int i = F.tid; i < TOPK; i += NTHR) SEL[(size_t)t * TOPK + i] = t - i; } continue; }
#endif
        const int nkeys = t0 + 4, ntile = (nkeys + 15) >> 4;
        if (F.tid < 4) { rs[F.tid].kmin = 0xffffffffu; rs[F.tid].kmax = 0u; }
        for (int i = F.tid; i < 4 * NBIN / 4; i += NTHR) ((LAS u32x4*)hist)[i] = (u32x4){0u, 0u, 0u, 0u};
        __syncthreads();
#ifdef PROBE_DOUBLE_SCORE
        for (int rep_ = 0; rep_ < 2; ++rep_)
#endif
        {
            bf16x8 aq[4][2]; float wq[4][4];
#pragma unroll
            for (int q = 0; q < 4; ++q) {
#pragma unroll
                for (int ks = 0; ks < 2; ++ks) aq[q][ks] = *(const bf16x8*)(QI + (size_t)(t0 + q) * 1024 + fr * 64 + ks * 32 + fq * 8);
                const f32x4 w4 = *(const f32x4*)(WI + (size_t)(t0 + q) * 16 + fq * 4);
#pragma unroll
                for (int j = 0; j < 4; ++j) wq[q][j] = 0.5f * w4[j];
            }
            float vmin = __builtin_inff(), vmax = -__builtin_inff();
            const int nmine = (ntile - wave + 7) >> 3;
            const int nchunk = (nmine + 3) >> 2;
            const int nslots = nchunk * 32; const int rot = (int)(((unsigned)wb * 37u + (unsigned)rnd * 11u) % (unsigned)nslots) & ~7;
#define IDX_KT(c, u) ({ int s_ = wave + 8 * (4 * (c) + (u)) + rot; s_ = s_ >= nslots ? s_ - nslots : s_; s_; })
#define IDX_LOAD(buf, c) do { _Pragma("unroll") for (int u_ = 0; u_ < 4; ++u_) { int kt2_ = IDX_KT(c, u_); kt2_ = kt2_ < T / 16 ? kt2_ : T / 16 - 1; \
                buf[u_][0] = *(const bf16x8*)(KI + ((size_t)(kt2_ * 2) * 64 + lane) * 8); buf[u_][1] = *(const bf16x8*)(KI + ((size_t)(kt2_ * 2 + 1) * 64 + lane) * 8); } } while (0)
#define IDX_COMPUTE(buf, c) do { f32x4 d_[4][4]; \
                _Pragma("unroll") for (int u_ = 0; u_ < 4; ++u_) _Pragma("unroll") for (int q_ = 0; q_ < 4; ++q_) { f32x4 z_ = (f32x4){0.f, 0.f, 0.f, 0.f}; \
                    z_ = __builtin_amdgcn_mfma_f32_16x16x32_bf16(aq[q_][0], buf[u_][0], z_, 0, 0, 0); d_[u_][q_] = __builtin_amdgcn_mfma_f32_16x16x32_bf16(aq[q_][1], buf[u_][1], z_, 0, 0, 0); } \
                _Pragma("unroll") for (int u_ = 0; u_ < 4; ++u_) { const int kt_ = IDX_KT(c, u_); float p_[4]; \
                    _Pragma("unroll") for (int q_ = 0; q_ < 4; ++q_) { const f32x4 x_ = d_[u_][q_]; \
                        p_[q_] = wq[q_][0] * (x_[0] + __builtin_fabsf(x_[0])) + wq[q_][1] * (x_[1] + __builtin_fabsf(x_[1])) + wq[q_][2] * (x_[2] + __builtin_fabsf(x_[2])) + wq[q_][3] * (x_[3] + __builtin_fabsf(x_[3])); } \
                    const auto r02_ = __builtin_amdgcn_permlane32_swap(f2u(p_[0]), f2u(p_[2]), false, false); const unsigned r020_ = r02_[0], r021_ = r02_[1]; \
                    const auto r13_ = __builtin_amdgcn_permlane32_swap(f2u(p_[1]), f2u(p_[3]), false, false); const unsigned r130_ = r13_[0], r131_ = r13_[1]; \
                    const float a_ = u2f(r020_) + u2f(r021_), b_ = u2f(r130_) + u2f(r131_); \
                    const auto rr_ = __builtin_amdgcn_permlane16_swap(f2u(a_), f2u(b_), false, false); const unsigned rr0_ = rr_[0], rr1_ = rr_[1]; \
                    const float tot_ = u2f(rr0_) + u2f(rr1_); \
                    const int key_ = kt_ * 16 + fr; if (key_ <= t0 + fq) { vmin = fminf(vmin, tot_); vmax = fmaxf(vmax, tot_); } \
                    if (kt_ < ntile) sc[fq * 8192 + key_] = tot_; } } while (0)
            bf16x8 bA[4][2], bB[4][2];
            IDX_LOAD(bA, 0);
            for (int c = 0; c < nchunk; c += 2) {
                __builtin_amdgcn_sched_barrier(0);
                IDX_LOAD(bB, c + 1);
                __builtin_amdgcn_sched_barrier(0);
                IDX_COMPUTE(bA, c);
#ifdef PROBE_COMPUTE2
                __builtin_amdgcn_sched_barrier(0);
                IDX_COMPUTE(bA, c);
#endif
                __builtin_amdgcn_sched_barrier(0);
                IDX_LOAD(bA, c + 2);
#ifdef PROBE_LOAD2
                __builtin_amdgcn_sched_barrier(0);
                { bf16x8 bC[4][2]; IDX_LOAD(bC, c + 3); asm volatile("" :: "v"(bC[0][0]), "v"(bC[1][0]), "v"(bC[2][0]), "v"(bC[3][0]), "v"(bC[0][1]), "v"(bC[1][1]), "v"(bC[2][1]), "v"(bC[3][1])); }
#endif
                __builtin_amdgcn_sched_barrier(0);
                IDX_COMPUTE(bB, c + 1);
#ifdef PROBE_COMPUTE2
                __builtin_amdgcn_sched_barrier(0);
                IDX_COMPUTE(bB, c + 1);
#endif
            }
#undef IDX_LOAD
#undef IDX_COMPUTE
#undef IDX_KT
            if (vmin <= vmax) { lds_min(&rs[fq].kmin, f2key(vmin)); lds_max(&rs[fq].kmax, f2key(vmax)); }
        }
        __syncthreads();
        const int q = wave >> 1, half = wave & 1, t = t0 + q, N = t + 1;
        const int sub = half * 64 + lane;
        LAS float* srow = sc + q * 8192;
        LAS unsigned* hrow = hist + q * NBIN;
        const int nit = (N + 511) >> 9;
        const unsigned long long ltmask = (1ull << lane) - 1ull;
#ifdef PROBE_DOUBLE_SEL
        for (int rep_ = 0; rep_ < 2; ++rep_) {
        if (rep_) { for (int i = sub; i < NBIN / 4; i += 128) ((LAS u32x4*)hrow)[i] = (u32x4){0u, 0u, 0u, 0u}; if (sub == 0) { rs[q].kmin = rs[q].cmin0; rs[q].kmax = rs[q].cmax0; } __syncthreads(); }
#endif
        int cur = half ? TOPK : 0;
        if (sub == 0) { rs[q].flo = key2f(rs[q].kmin); const float fhi0 = key2f(rs[q].kmax); const float rg = fhi0 - rs[q].flo; rs[q].scale = (rg > 0.f) ? (float)NBIN / rg : 0.f;
            rs[q].need = TOPK; rs[q].nout = 0u; rs[q].done = 0; rs[q].level = 0; rs[q].cmin = rs[q].kmin; rs[q].cmax = rs[q].kmax; rs[q].cmin0 = rs[q].kmin; rs[q].cmax0 = rs[q].kmax; rs[q].kmin = 0xffffffffu; rs[q].kmax = 0u; rs[q].ncand = 0u; }
        __syncthreads();
        for (int level = 0; level < 40; ++level) {
            const int alldone = rs[0].done & rs[1].done & rs[2].done & rs[3].done;
            if (alldone) break;
            const bool active = !rs[q].done;
            const float flo = rs[q].flo, scale = rs[q].scale; const float fhi = key2f(rs[q].cmax);
            const bool allsame = (rs[q].cmin == rs[q].cmax);
            if (level > 0) { for (int i = sub; i < NBIN / 4; i += 128) ((LAS u32x4*)hrow)[i] = (u32x4){0u, 0u, 0u, 0u}; __syncthreads(); }
            if (active && !allsame) {
                for (int it = 0; it < nit; ++it) { const int i0 = it * 512 + sub * 4; const f32x4 s4 = *(const LAS f32x4*)(srow + i0);
#pragma unroll
                    for (int e = 0; e < 4; ++e) { const float s = s4[e];
                        if (i0 + e < N && s >= flo && s <= fhi) { const int b = (int)fminf(fmaxf((s - flo) * scale, 0.f), (float)(NBIN - 1)); lds_add(&hrow[b], 1u); } } }
            }
            __syncthreads();
            if (active && !allsame && half == 0) {
                unsigned loc = 0;
#pragma unroll
                for (int j = 0; j < 4; ++j) { const u32x4 h4 = ((const LAS u32x4*)hrow)[lane * 4 + j]; loc += (h4.x + h4.y) + (h4.z + h4.w); }
                unsigned suf = loc;
#pragma unroll
                for (int o = 1; o < 64; o <<= 1) { const unsigned v = __shfl_down(suf, o); if (lane + o < 64) suf += v; }
                const unsigned above_lane = suf - loc; const unsigned need = (unsigned)rs[q].need;
                if (above_lane < need && suf >= need) {
                    unsigned ab = above_lane; int b = lane * 16 + 15;
                    for (;; --b) { const unsigned h = hrow[b]; if (ab + h >= need) { rs[q].bstar = b; rs[q].cabove = (int)ab; rs[q].cstar = (int)h; break; } ab += h; }
                }
            }
            __syncthreads();
            if (active) {
                if (allsame) {
                    if (half == 0) {
                        unsigned need = (unsigned)rs[q].need; unsigned base = (unsigned)cur;
                        for (int i0 = 0; i0 < N && need > 0; i0 += 64) { const int i = i0 + lane; const bool m = (i < N) && (srow[i] >= flo && srow[i] <= fhi);
                            const unsigned long long mask = __ballot(m); const unsigned pos = __builtin_popcountll(mask & ltmask);
                            if (m && pos < need) SEL[(size_t)t * TOPK + base + pos] = i;
                            const unsigned c = (unsigned)__builtin_popcountll(mask); const unsigned take = c < need ? c : need; base += take; need -= take; }
                        if (lane == 0) { rs[q].done = 1; }
                    }
                } else {
                    const int bstar = rs[q].bstar, cstar = rs[q].cstar; const bool collect = cstar <= CAND_CAP;
                    unsigned lmin = 0xffffffffu, lmax = 0u;
                    for (int it = 0; it < nit; ++it) { const int i0 = it * 512 + sub * 4; const f32x4 s4 = *(const LAS f32x4*)(srow + i0);
#pragma unroll
                        for (int e = 0; e < 4; ++e) { const float s = s4[e]; const int i = i0 + e; bool em = false, cd = false;
                            if (i < N && s >= flo && s <= fhi) { const int b = (int)fminf(fmaxf((s - flo) * scale, 0.f), (float)(NBIN - 1)); em = b > bstar; cd = b == bstar; }
                            const unsigned long long me = __ballot(em); const int ne = __builtin_popcountll(me); const int rk = __builtin_popcountll(me & ltmask);
                            if (em) SEL[(size_t)t * TOPK + (half ? (cur - 1 - rk) : (cur + rk))] = i;
                            cur = half ? cur - ne : cur + ne;
                            const unsigned long long mc = __ballot(cd);
                            if (mc) {
                                if (collect) { unsigned base = 0; if (lane == 0) base = lds_add(&rs[q].ncand, (unsigned)__builtin_popcountll(mc)); base = __shfl(base, 0);
                                    if (cd) { const unsigned p = base + __builtin_popcountll(mc & ltmask); hrow[p] = __builtin_bit_cast(unsigned, s); hrow[CAND_CAP + p] = (unsigned)i; } }
                                else if (cd) { const unsigned k = f2key(s); lmin = k < lmin ? k : lmin; lmax = k > lmax ? k : lmax; }
                            } } }
                    if (!collect && lmin <= lmax) { lds_min(&rs[q].kmin, lmin); lds_max(&rs[q].kmax, lmax); }
                    if (half == 0 && lane == 0) rs[q].nout = (unsigned)cur;
                }
            }
            __syncthreads();
            if (active && !allsame) {
                const int cstar = rs[q].cstar; const int need2 = rs[q].need - rs[q].cabove;
                if (cstar <= CAND_CAP) {
                    const unsigned nout = rs[q].nout;
                    for (int i = sub; i < cstar; i += 128) { const float s = __builtin_bit_cast(float, hrow[i]); const unsigned id = hrow[CAND_CAP + i]; int rank = 0;
                        for (int j = 0; j < cstar; ++j) { const float sj = __builtin_bit_cast(float, hrow[j]); const unsigned idj = hrow[CAND_CAP + j]; rank += (sj > s || (sj == s && idj < id)) ? 1 : 0; }
                        if (rank < need2) SEL[(size_t)t * TOPK + nout + rank] = (int)id; }
                }
            }
            __syncthreads();
            if (sub == 0 && active && !allsame) {
                if (rs[q].cstar <= CAND_CAP) rs[q].done = 1;
                else {
                    rs[q].need = rs[q].need - rs[q].cabove;
                    rs[q].cmin = rs[q].kmin; rs[q].cmax = rs[q].kmax;
                    const float nlo = key2f(rs[q].kmin), nhi = key2f(rs[q].kmax); rs[q].flo = nlo; const float rg = nhi - nlo; rs[q].scale = (rg > 0.f) ? (float)NBIN / rg : 0.f;
                    rs[q].kmin = 0xffffffffu; rs[q].kmax = 0u; rs[q].ncand = 0u;
                }
            }
            __syncthreads();
        }
#ifdef PROBE_DOUBLE_SEL
        __syncthreads(); }
#endif
        __syncthreads();
    }
}

__device__ __forceinline__ void phase_attn_simple(const Frame& F) {
    const bf16_t* Q = (const bf16_t*)(F.ws + WS_Q); const bf16_t* Kb = (const bf16_t*)(F.ws + WS_K); const bf16_t* Vb = (const bf16_t*)(F.ws + WS_V); const int* SEL = (const int*)(F.ws + WS_SEL);
    bf16_t* YA = (bf16_t*)(F.ws + WS_YA);
    LAS float* qs = (LAS float*)(F.lds + F.wave * 8192);
    LAS float* ps = qs + 512;
    const int lane = F.lane;
    const float scale = 0.08838834764831845f;
#pragma unroll 1
    for (int task = F.gw; task < T * NKV; task += F.NGW) {
        const int t = task >> 1, kvh = task & 1; const int nsel = (t + 1) < TOPK ? (t + 1) : TOPK;
#pragma unroll
        for (int i = 0; i < 8; ++i) { const int e = i * 64 + lane; qs[e] = bf2f(Q[(size_t)t * AW + kvh * 512 + e]); }
        LDS_WAIT(); asm volatile("" ::: "memory");
        float mx0 = -__builtin_inff(), mx1 = mx0, mx2 = mx0, mx3 = mx0;
#pragma unroll 1
        for (int s = 0; s < 4; ++s) {
            const int pos = s * 64 + lane; const bool valid = pos < nsel; const int key = valid ? SEL[(size_t)t * TOPK + pos] : 0;
            const bf16_t* kr = Kb + (size_t)key * 256 + kvh * 128;
            float a0 = 0.f, a1 = 0.f, a2 = 0.f, a3 = 0.f;
#pragma unroll 2
            for (int c = 0; c < 16; ++c) { const u32x4 kk = *(const u32x4*)(kr + c * 8);
                const float k0 = bflo(kk.x), k1 = bfhi(kk.x), k2 = bflo(kk.y), k3 = bfhi(kk.y), k4 = bflo(kk.z), k5 = bfhi(kk.z), k6 = bflo(kk.w), k7 = bfhi(kk.w);
#define DOT8(h, acc_) { const f32x4 qa = *(const LAS f32x4*)(qs + (h) * 128 + c * 8), qb = *(const LAS f32x4*)(qs + (h) * 128 + c * 8 + 4); \
                acc_ += qa[0] * k0 + qa[1] * k1 + qa[2] * k2 + qa[3] * k3 + qb[0] * k4 + qb[1] * k5 + qb[2] * k6 + qb[3] * k7; }
                DOT8(0, a0) DOT8(1, a1) DOT8(2, a2) DOT8(3, a3)
#undef DOT8
            }
            const float ninf = -__builtin_inff();
            a0 = valid ? a0 * scale : ninf; a1 = valid ? a1 * scale : ninf; a2 = valid ? a2 * scale : ninf; a3 = valid ? a3 * scale : ninf;
            mx0 = fmaxf(mx0, a0); mx1 = fmaxf(mx1, a1); mx2 = fmaxf(mx2, a2); mx3 = fmaxf(mx3, a3);
            *(LAS f32x4*)(ps + pos * 4) = (f32x4){a0, a1, a2, a3};
        }
#pragma unroll
        for (int o = 1; o < 64; o <<= 1) { mx0 = fmaxf(mx0, __shfl_xor(mx0, o)); mx1 = fmaxf(mx1, __shfl_xor(mx1, o)); mx2 = fmaxf(mx2, __shfl_xor(mx2, o)); mx3 = fmaxf(mx3, __shfl_xor(mx3, o)); }
        LDS_WAIT(); asm volatile("" ::: "memory");
        float s0 = 0.f, s1 = 0.f, s2 = 0.f, s3 = 0.f;
#pragma unroll 1
        for (int s = 0; s < 4; ++s) { const int pos = s * 64 + lane; f32x4 l = *(const LAS f32x4*)(ps + pos * 4);
            l[0] = __builtin_amdgcn_exp2f((l[0] - mx0) * 1.4426950408889634f); l[1] = __builtin_amdgcn_exp2f((l[1] - mx1) * 1.4426950408889634f);
            l[2] = __builtin_amdgcn_exp2f((l[2] - mx2) * 1.4426950408889634f); l[3] = __builtin_amdgcn_exp2f((l[3] - mx3) * 1.4426950408889634f);
            s0 += l[0]; s1 += l[1]; s2 += l[2]; s3 += l[3];
            *(LAS f32x4*)(ps + pos * 4) = l; }
        s0 = wave_sum(s0); s1 = wave_sum(s1); s2 = wave_sum(s2); s3 = wave_sum(s3);
#ifdef PROBE_ATTN_ZERO
        const float i0 = 0.f, i1 = 0.f, i2 = 0.f, i3 = 0.f; (void)s0; (void)s1; (void)s2; (void)s3;
#else
        const float i0 = 1.0f / s0, i1 = 1.0f / s1, i2 = 1.0f / s2, i3 = 1.0f / s3;
#endif
        LDS_WAIT(); asm volatile("" ::: "memory");
        float o00 = 0.f, o01 = 0.f, o10 = 0.f, o11 = 0.f, o20 = 0.f, o21 = 0.f, o30 = 0.f, o31 = 0.f;
#pragma unroll 1
        for (int n0 = 0; n0 < nsel; n0 += 8) {
            unsigned vv[8];
#pragma unroll
            for (int j = 0; j < 8; ++j) { const int key = (n0 + j < nsel) ? SEL[(size_t)t * TOPK + n0 + j] : 0; vv[j] = *(const unsigned*)(Vb + (size_t)key * 256 + kvh * 128 + 2 * lane); }
#pragma unroll
            for (int j = 0; j < 8; ++j) { const f32x4 p = *(const LAS f32x4*)(ps + (n0 + j) * 4); const float v0 = bflo(vv[j]), v1 = bfhi(vv[j]);
                o00 += p[0] * v0; o01 += p[0] * v1; o10 += p[1] * v0; o11 += p[1] * v1; o20 += p[2] * v0; o21 += p[2] * v1; o30 += p[3] * v0; o31 += p[3] * v1; } }
        bf16_t* yo = YA + (size_t)t * AW + kvh * 512 + 2 * lane;
        *(unsigned*)(yo) = cvt_pk_bf16(o00 * i0, o01 * i0); *(unsigned*)(yo + 128) = cvt_pk_bf16(o10 * i1, o11 * i1);
        *(unsigned*)(yo + 256) = cvt_pk_bf16(o20 * i2, o21 * i2); *(unsigned*)(yo + 384) = cvt_pk_bf16(o30 * i3, o31 * i3);
        LDS_WAIT(); asm volatile("" ::: "memory");
    }
}

typedef short s16x4 __attribute__((ext_vector_type(4)));
template <int OFF> __device__ __forceinline__ s16x4 tr_read(unsigned a) { s16x4 r; asm volatile("ds_read_b64_tr_b16 %0, %1 offset:%2" : "=&v"(r) : "v"(a), "i"(OFF) : "memory"); return r; }
__device__ __forceinline__ unsigned off_b(unsigned row, unsigned ch) { return 256u * row + 16u * (ch ^ (((row & 3u) << 2) | ((row >> 2) & 3u))); }

template <int BUF> __device__ __forceinline__ void attn_pv_step(f32x4 (&oacc)[8], const unsigned (&tra)[8][2], const bf16x8 pf) {
    s16x4 lo[8], hi[8];
#pragma unroll
    for (int c = 0; c < 8; ++c) { lo[c] = tr_read<BUF * 8192>(tra[c][0]); hi[c] = tr_read<BUF * 8192>(tra[c][1]); }
    asm volatile("s_waitcnt lgkmcnt(0)" ::: "memory"); __builtin_amdgcn_sched_barrier(0);
#pragma unroll
    for (int c = 0; c < 8; ++c) { const bf16x8 a = (bf16x8){lo[c][0], lo[c][1], lo[c][2], lo[c][3], hi[c][0], hi[c][1], hi[c][2], hi[c][3]};
        oacc[c] = __builtin_amdgcn_mfma_f32_16x16x32_bf16(a, pf, oacc[c], 0, 0, 0); }
}

__device__ __forceinline__ void phase_attn_mfma(const Frame& F, int wb, int wG) {
    const bf16_t* Q = (const bf16_t*)(F.ws + WS_Q); const bf16_t* Kb = (const bf16_t*)(F.ws + WS_K); const bf16_t* Vb = (const bf16_t*)(F.ws + WS_V); const int* SEL = (const int*)(F.ws + WS_SEL);
    bf16_t* YA = (bf16_t*)(F.ws + WS_YA);
    const int lane = F.lane, fr = lane & 15, fq = lane >> 4;
    LAS unsigned char* wl = F.lds + F.wave * 16384;
    LAS int* selw = (LAS int*)(F.lds + LDS_AUX + F.wave * 1024);
    const unsigned wl_addr = (unsigned)(size_t)wl;
    unsigned tra[8][2];
    { const unsigned g = fq, q = (lane & 15) >> 2, p = lane & 3;
#pragma unroll
      for (int c = 0; c < 8; ++c)
#pragma unroll
          for (int t2 = 0; t2 < 2; ++t2) tra[c][t2] = wl_addr + off_b(8 * g + 4 * t2 + q, 2 * c + (p >> 1)) + 8 * (p & 1); }
    const float c2 = 0.08838834764831845f * 1.4426950408889634f;
#pragma unroll 1
    for (int task = wb * NWAVES + F.wave; task < T * NKV; task += wG * NWAVES) {
        const int t = task >> 1, kvh = task & 1; const int nsel = (t + 1) < TOPK ? (t + 1) : TOPK;
#pragma unroll
        for (int i = 0; i < 4; ++i) { const int pos = i * 64 + lane; selw[pos] = (pos < nsel) ? SEL[(size_t)t * TOPK + pos] : 0; }
        LDS_WAIT(); asm volatile("" ::: "memory");
        const bf16_t* Vh = Vb + kvh * 128; const bf16_t* Kh = Kb + kvh * 128;
#define ATTN_DMA(ks, buf) do { _Pragma("unroll") for (int i_ = 0; i_ < 8; ++i_) { const int row_ = 4 * i_ + fq; const int key_ = selw[(ks) * 32 + row_]; \
            const unsigned ch_ = (unsigned)fr ^ ((((unsigned)row_ & 3u) << 2) | (((unsigned)row_ >> 2) & 3u)); \
            __builtin_amdgcn_global_load_lds((const unsigned*)(Vh + (size_t)key_ * 256 + ch_ * 8), (LAS unsigned*)(wl + (buf) * 8192 + i_ * 1024), 16, 0, 0); } } while (0)
        ATTN_DMA(0, 0); ATTN_DMA(1, 1);
        bf16x8 qf[4];
#pragma unroll
        for (int ks = 0; ks < 4; ++ks) { qf[ks] = (bf16x8){0, 0, 0, 0, 0, 0, 0, 0}; if (fr < 4) qf[ks] = *(const bf16x8*)(Q + (size_t)t * AW + (kvh * 4 + fr) * 128 + ks * 32 + fq * 8); }
        f32x4 sacc[16];
#pragma unroll
        for (int tt = 0; tt < 16; ++tt) {
            const int pos = 32 * (tt >> 1) + 8 * (fr >> 2) + 4 * (tt & 1) + (fr & 3);
            const int key = selw[pos];
            const bf16_t* kr = Kh + (size_t)key * 256 + fq * 8;
            const bf16x8 k0 = *(const bf16x8*)(kr), k1 = *(const bf16x8*)(kr + 32), k2 = *(const bf16x8*)(kr + 64), k3 = *(const bf16x8*)(kr + 96);
            f32x4 d = (f32x4){0.f, 0.f, 0.f, 0.f};
            d = __builtin_amdgcn_mfma_f32_16x16x32_bf16(k0, qf[0], d, 0, 0, 0);
            d = __builtin_amdgcn_mfma_f32_16x16x32_bf16(k1, qf[1], d, 0, 0, 0);
            d = __builtin_amdgcn_mfma_f32_16x16x32_bf16(k2, qf[2], d, 0, 0, 0);
            d = __builtin_amdgcn_mfma_f32_16x16x32_bf16(k3, qf[3], d, 0, 0, 0);
            sacc[tt] = d;
        }
        float m = -__builtin_inff();
#pragma unroll
        for (int tt = 0; tt < 16; ++tt)
#pragma unroll
            for (int j = 0; j < 4; ++j) { const int pos = 32 * (tt >> 1) + 8 * fq + 4 * (tt & 1) + j; const float v = (pos < nsel) ? sacc[tt][j] : -__builtin_inff(); sacc[tt][j] = v; m = fmaxf(m, v); }
        m = fmaxf(m, __shfl_xor(m, 16)); m = fmaxf(m, __shfl_xor(m, 32));
        float sum = 0.f; const float mc = m * c2;
#pragma unroll
        for (int tt = 0; tt < 16; ++tt)
#pragma unroll
            for (int j = 0; j < 4; ++j) { const float p = __builtin_amdgcn_exp2f(sacc[tt][j] * c2 - mc); sacc[tt][j] = p; sum += p; }
        sum += __shfl_xor(sum, 16); sum += __shfl_xor(sum, 32);
        const float inv = 1.0f / sum;
        bf16x8 pf[8];
#pragma unroll
        for (int ks = 0; ks < 8; ++ks) { u32x4 w; w.x = cvt_pk_bf16(sacc[2 * ks][0], sacc[2 * ks][1]); w.y = cvt_pk_bf16(sacc[2 * ks][2], sacc[2 * ks][3]);
            w.z = cvt_pk_bf16(sacc[2 * ks + 1][0], sacc[2 * ks + 1][1]); w.w = cvt_pk_bf16(sacc[2 * ks + 1][2], sacc[2 * ks + 1][3]); pf[ks] = __builtin_bit_cast(bf16x8, w); }
        f32x4 oacc[8];
#pragma unroll
        for (int c = 0; c < 8; ++c) oacc[c] = (f32x4){0.f, 0.f, 0.f, 0.f};
#pragma unroll
        for (int ks = 0; ks < 8; ++ks) {
            if (ks < 7) asm volatile("s_waitcnt vmcnt(8)" ::: "memory"); else asm volatile("s_waitcnt vmcnt(0)" ::: "memory");
            if (ks & 1) attn_pv_step<1>(oacc, tra, pf[ks]); else attn_pv_step<0>(oacc, tra, pf[ks]);
            if (ks + 2 < 8) { if (ks & 1) ATTN_DMA(ks + 2, 1); else ATTN_DMA(ks + 2, 0); }
        }
#undef ATTN_DMA
        if (fr < 4) { bf16_t* yo = YA + (size_t)t * AW + (kvh * 4 + fr) * 128 + fq * 4;
#pragma unroll
            for (int c = 0; c < 8; ++c) { u32x2 w; w.x = cvt_pk_bf16(oacc[c][0] * inv, oacc[c][1] * inv); w.y = cvt_pk_bf16(oacc[c][2] * inv, oacc[c][3] * inv); *(u32x2*)(yo + c * 16) = w; } }
        LDS_WAIT(); asm volatile("" ::: "memory");
    }
}

#define AT_KSLOT(f) (((f) & 3) * 4096)
#define AT_FILL_K(SW, KH, tt) do { _Pragma("unroll") for (int j_ = 0; j_ < 4; ++j_) { const int r_ = 4 * j_ + fq; const int pos_ = 32 * ((tt) >> 1) + 8 * (r_ >> 2) + 4 * ((tt) & 1) + (r_ & 3); \
        const int key_ = (SW)[pos_]; const unsigned ch_ = (unsigned)fr ^ ((((unsigned)r_ & 3u) << 2) | (((unsigned)r_ >> 2) & 3u)); \
        __builtin_amdgcn_global_load_lds((const unsigned*)((KH) + (size_t)key_ * 256 + ch_ * 8), (LAS unsigned*)(wl + AT_KSLOT(tt) + j_ * 1024), 16, 0, 0); } } while (0)
#define AT_FILL_V(SW, VH, g) do { _Pragma("unroll") for (int j_ = 0; j_ < 4; ++j_) { const int row_ = 16 * ((g) & 1) + 4 * j_ + fq; const int key_ = (SW)[((g) >> 1) * 32 + row_]; \
        const unsigned ch_ = (unsigned)fr ^ ((((unsigned)row_ & 3u) << 2) | (((unsigned)row_ >> 2) & 3u)); \
        __builtin_amdgcn_global_load_lds((const unsigned*)((VH) + (size_t)key_ * 256 + ch_ * 8), (LAS unsigned*)(wl + AT_KSLOT(g) + j_ * 1024), 16, 0, 0); } } while (0)
#define AT_ISSUE(F) do { if ((F) < 16) AT_FILL_K(selc, Khc, (F)); else if ((F) < 32) AT_FILL_V(selc, Vhc, (F) - 16); else if (has_next) AT_FILL_K(seln, Khn, (F) - 32); } while (0)

__device__ __forceinline__ void phase_attn_stream(const Frame& F, int wb, int wG) {
    const bf16_t* Q = (const bf16_t*)(F.ws + WS_Q); const bf16_t* Kb = (const bf16_t*)(F.ws + WS_K); const bf16_t* Vb = (const bf16_t*)(F.ws + WS_V); const int* SEL = (const int*)(F.ws + WS_SEL);
    bf16_t* YA = (bf16_t*)(F.ws + WS_YA);
    const int lane = F.lane, fr = lane & 15, fq = lane >> 4;
    LAS unsigned char* wl = F.lds + F.wave * 16384;
    LAS int* selc = (LAS int*)(F.lds + LDS_AUX + F.wave * 2048);
    LAS int* seln = selc + 256;
    const unsigned wl_addr = (unsigned)(size_t)wl;
    unsigned tra[8][2];
    { const unsigned g = fq, q = (lane & 15) >> 2, p = lane & 3;
#pragma unroll
      for (int c = 0; c < 8; ++c)
#pragma unroll
          for (int t2 = 0; t2 < 2; ++t2) tra[c][t2] = wl_addr + off_b(8 * g + 4 * t2 + q, 2 * c + (p >> 1)) + 8 * (p & 1); }
    unsigned kra[4];
#pragma unroll
    for (int ks = 0; ks < 4; ++ks) kra[ks] = off_b((unsigned)fr, (unsigned)(4 * ks + fq));
    const float c2 = 0.08838834764831845f * 1.4426950408889634f;
    const int stride = wG * NWAVES, ntask = T * NKV;
    int task = wb * NWAVES + F.wave;
    if (task >= ntask) return;
    int t = task >> 1, kvh = task & 1; int nsel = (t + 1) < TOPK ? (t + 1) : TOPK;
#pragma unroll
    for (int i = 0; i < 4; ++i) { const int pos = i * 64 + lane; selc[pos] = (pos < nsel) ? SEL[(size_t)t * TOPK + pos] : 0; }
    bf16x8 qf[4];
#pragma unroll
    for (int ks = 0; ks < 4; ++ks) { qf[ks] = (bf16x8){0, 0, 0, 0, 0, 0, 0, 0}; if (fr < 4) qf[ks] = *(const bf16x8*)(Q + (size_t)t * AW + (kvh * 4 + fr) * 128 + ks * 32 + fq * 8); }
    LDS_WAIT(); asm volatile("" ::: "memory");
    asm volatile("" : "+v"(qf[0]), "+v"(qf[1]), "+v"(qf[2]), "+v"(qf[3]));
    const bf16_t* Khc = Kb + kvh * 128; const bf16_t* Vhc = Vb + kvh * 128;
    { const bool has_next = false; const bf16_t* Khn = Khc; AT_ISSUE(0); AT_ISSUE(1); AT_ISSUE(2); AT_ISSUE(3); (void)has_next; (void)Khn; }
#pragma unroll 1
    for (;;) {
        const int ntk = task + stride; const bool has_next = ntk < ntask;
        const int tn = has_next ? (ntk >> 1) : t, kvhn = has_next ? (ntk & 1) : kvh; const int nseln = (tn + 1) < TOPK ? (tn + 1) : TOPK;
        const bf16_t* Khn = Kb + kvhn * 128; const bf16_t* Vhn = Vb + kvhn * 128;
        int sn[4]; bf16x8 qn[4];
#pragma unroll
        for (int i = 0; i < 4; ++i) { const int pos = i * 64 + lane; sn[i] = (has_next && pos < nseln) ? SEL[(size_t)tn * TOPK + pos] : 0; }
#pragma unroll
        for (int ks = 0; ks < 4; ++ks) { qn[ks] = (bf16x8){0, 0, 0, 0, 0, 0, 0, 0}; if (has_next && fr < 4) qn[ks] = *(const bf16x8*)(Q + (size_t)tn * AW + (kvhn * 4 + fr) * 128 + ks * 32 + fq * 8); }
        f32x4 sacc[16];
#pragma unroll
        for (int tt = 0; tt < 16; ++tt) {
            asm volatile("s_waitcnt vmcnt(12)" ::: "memory");
            const LAS unsigned char* kb = wl + AT_KSLOT(tt);
            const bf16x8 k0 = *(const LAS bf16x8*)(kb + kra[0]), k1 = *(const LAS bf16x8*)(kb + kra[1]), k2 = *(const LAS bf16x8*)(kb + kra[2]), k3 = *(const LAS bf16x8*)(kb + kra[3]);
            LDS_WAIT(); asm volatile("" ::: "memory");
            AT_ISSUE(tt + 4);
            f32x4 d = (f32x4){0.f, 0.f, 0.f, 0.f};
            d = __builtin_amdgcn_mfma_f32_16x16x32_bf16(k0, qf[0], d, 0, 0, 0);
            d = __builtin_amdgcn_mfma_f32_16x16x32_bf16(k1, qf[1], d, 0, 0, 0);
            d = __builtin_amdgcn_mfma_f32_16x16x32_bf16(k2, qf[2], d, 0, 0, 0);
            d = __builtin_amdgcn_mfma_f32_16x16x32_bf16(k3, qf[3], d, 0, 0, 0);
            sacc[tt] = d;
        }
#pragma unroll
        for (int i = 0; i < 4; ++i) seln[i * 64 + lane] = sn[i];
        asm volatile("" : "+v"(qn[0]), "+v"(qn[1]), "+v"(qn[2]), "+v"(qn[3]));
        float m = -__builtin_inff();
#pragma unroll
        for (int tt = 0; tt < 16; ++tt)
#pragma unroll
            for (int j = 0; j < 4; ++j) { const int pos = 32 * (tt >> 1) + 8 * fq + 4 * (tt & 1) + j; const float v = (pos < nsel) ? sacc[tt][j] : -__builtin_inff(); sacc[tt][j] = v; m = fmaxf(m, v); }
        m = fmaxf(m, __shfl_xor(m, 16)); m = fmaxf(m, __shfl_xor(m, 32));
        float sum = 0.f; const float mc = m * c2;
#pragma unroll
        for (int tt = 0; tt < 16; ++tt)
#pragma unroll
            for (int j = 0; j < 4; ++j) { const float p = __builtin_amdgcn_exp2f(sacc[tt][j] * c2 - mc); sacc[tt][j] = p; sum += p; }
        sum += __shfl_xor(sum, 16); sum += __shfl_xor(sum, 32);
        const float inv = 16.0f / sum;
        bf16x8 pf[8];
#pragma unroll
        for (int ks = 0; ks < 8; ++ks) { u32x4 w; w.x = cvt_pk_bf16(sacc[2 * ks][0], sacc[2 * ks][1]); w.y = cvt_pk_bf16(sacc[2 * ks][2], sacc[2 * ks][3]);
            w.z = cvt_pk_bf16(sacc[2 * ks + 1][0], sacc[2 * ks + 1][1]); w.w = cvt_pk_bf16(sacc[2 * ks + 1][2], sacc[2 * ks + 1][3]); pf[ks] = __builtin_bit_cast(bf16x8, w); }
        f32x4 oacc[8];
#pragma unroll
        for (int c = 0; c < 8; ++c) oacc[c] = (f32x4){0.f, 0.f, 0.f, 0.f};
        LDS_WAIT(); asm volatile("" ::: "memory");
#pragma unroll
        for (int ks = 0; ks < 8; ++ks) {
            if (ks < 7 || has_next) asm volatile("s_waitcnt vmcnt(8)" ::: "memory"); else asm volatile("s_waitcnt vmcnt(0)" ::: "memory");
            if (ks & 1) attn_pv_step<1>(oacc, tra, pf[ks]); else attn_pv_step<0>(oacc, tra, pf[ks]);
            AT_ISSUE(20 + 2 * ks); AT_ISSUE(21 + 2 * ks);
        }
        if (fr < 4) { unsigned char* yo = (unsigned char*)YA + (size_t)t * AW + (kvh * 4 + fr) * 128 + fq * 4;
#pragma unroll
            for (int c = 0; c < 8; ++c) *(unsigned*)(yo + c * 16) = pk4_fp8(oacc[c][0] * inv, oacc[c][1] * inv, oacc[c][2] * inv, oacc[c][3] * inv); }
        if (!has_next) break;
        task = ntk; t = tn; kvh = kvhn; nsel = nseln; Khc = Khn; Vhc = Vhn;
#pragma unroll
        for (int ks = 0; ks < 4; ++ks) qf[ks] = qn[ks];
        { LAS int* tmp = selc; selc = seln; seln = tmp; }
    }
    asm volatile("s_waitcnt vmcnt(0)" ::: "memory");
}
#undef AT_ISSUE
#undef AT_FILL_K
#undef AT_FILL_V
#undef AT_KSLOT

__device__ __forceinline__ void phase_ln1_route(const Frame& F, const float* g1, const float* b1, const float* rbias) {
    const bf16_t* PRE = (const bf16_t*)(F.ws + WS_PRE1); bf16_t* H1B = (bf16_t*)(F.ws + WS_H1B); unsigned char* H18 = F.ws + WS_H18;
    const bf16_t* RH = (const bf16_t*)(F.ws + WS_RT); const bf16_t* RL = RH + (size_t)NE * D;
    unsigned* cnt = (unsigned*)(F.ws + WS_CTL) + CW_CNT; int* TOKL = (int*)(F.ws + WS_TOKL); int* SLOT = (int*)(F.ws + WS_SLOT); float* GATE = (float*)(F.ws + WS_GATE);
    LAS bf16_t* hh = (LAS bf16_t*)F.lds;
    LAS bf16_t* hl = (LAS bf16_t*)(F.lds + 16 * 2056 * 2);
    LAS float* lg = (LAS float*)(F.lds + 2 * 16 * 2056 * 2);
    LAS float* gbuf = lg + 16 * 64;
    LAS unsigned long long* smask = (LAS unsigned long long*)(gbuf + 16 * 64);
    const int lane = F.lane, wave = F.wave, fr = lane & 15, fq = lane >> 4;
    const float bias_l = rbias[lane];
    for (int task = blockIdx.x; task < T / 16; task += F.G) {
        const int r0 = task * 16;
        int zero_; asm volatile("s_mov_b32 %0, 0" : "=s"(zero_));
        const float* g1t = g1 + zero_; const float* b1t = b1 + zero_; const bf16_t* RHt = RH + zero_; const bf16_t* RLt = RL + zero_;
        for (int i = F.tid; i < 16 * 64; i += NTHR) lg[i] = 0.f;
        {
            f32x4 v[2][8]; float s[2] = {0.f, 0.f};
#pragma unroll
            for (int rr = 0; rr < 2; ++rr) { const u32x2* xr = (const u32x2*)(PRE + (size_t)(r0 + wave * 2 + rr) * D) + lane;
#pragma unroll
                for (int j = 0; j < 8; ++j) { const u32x2 w = xr[64 * j]; v[rr][j] = (f32x4){bflo(w.x), bfhi(w.x), bflo(w.y), bfhi(w.y)}; } }
#pragma unroll
            for (int rr = 0; rr < 2; ++rr)
#pragma unroll
                for (int j = 0; j < 8; ++j) s[rr] += (v[rr][j][0] + v[rr][j][1]) + (v[rr][j][2] + v[rr][j][3]);
#pragma unroll
            for (int rr = 0; rr < 2; ++rr) {
                const int lr = wave * 2 + rr; const size_t row = (size_t)(r0 + lr);
                const float mean = wave_sum(s[rr]) * (1.f / D); float s2 = 0.f;
#pragma unroll
                for (int j = 0; j < 8; ++j) { v[rr][j] = v[rr][j] - mean; s2 += (v[rr][j][0] * v[rr][j][0] + v[rr][j][1] * v[rr][j][1]) + (v[rr][j][2] * v[rr][j][2] + v[rr][j][3] * v[rr][j][3]); }
                const float rstd = 1.0f / sqrtf(wave_sum(s2) * (1.f / D) + LN_EPS);
#pragma unroll
                for (int j = 0; j < 8; ++j) { const int c = 4 * lane + 256 * j; const f32x4 gg = *(const f32x4*)(g1t + c), bb = *(const f32x4*)(b1t + c);
                    f32x4 y; unsigned hi[4]; float lo[4];
#pragma unroll
                    for (int e = 0; e < 4; ++e) { y[e] = v[rr][j][e] * rstd * gg[e] + bb[e]; hi[e] = f2bf(y[e]); lo[e] = y[e] - bf2f(hi[e]); }
                    u32x2 wh; wh.x = hi[0] | (hi[1] << 16); wh.y = hi[2] | (hi[3] << 16);
                    *(u32x2*)(H1B + row * D + c) = wh;
                    *(unsigned*)(H18 + row * D + c) = pk4_fp8(y[0], y[1], y[2], y[3]);
                    *(LAS u32x2*)(hh + lr * 2056 + c) = wh;
                    u32x2 wl; wl.x = cvt_pk_bf16(lo[0], lo[1]); wl.y = cvt_pk_bf16(lo[2], lo[3]);
                    *(LAS u32x2*)(hl + lr * 2056 + c) = wl; }
            }
        }
        __syncthreads();
        {
            f32x4 dacc[4];
#pragma unroll
            for (int et = 0; et < 4; ++et) dacc[et] = (f32x4){0.f, 0.f, 0.f, 0.f};
#pragma unroll
            for (int kh = 0; kh < 4; ++kh) {
                bf16x8 bh[2][4], bl[2][4];
#pragma unroll
                for (int k4 = 0; k4 < 2; ++k4)
#pragma unroll
                    for (int et = 0; et < 4; ++et) { const int k0 = wave * 256 + (kh * 2 + k4) * 32 + fq * 8;
                        bh[k4][et] = *(const bf16x8*)(RHt + (size_t)(et * 16 + fr) * D + k0); bl[k4][et] = *(const bf16x8*)(RLt + (size_t)(et * 16 + fr) * D + k0); }
#pragma unroll
                for (int k4 = 0; k4 < 2; ++k4) { const int k0 = wave * 256 + (kh * 2 + k4) * 32 + fq * 8;
                    const bf16x8 ah = *(const LAS bf16x8*)(hh + fr * 2056 + k0), al = *(const LAS bf16x8*)(hl + fr * 2056 + k0);
#pragma unroll
                    for (int et = 0; et < 4; ++et) {
                        dacc[et] = __builtin_amdgcn_mfma_f32_16x16x32_bf16(ah, bh[k4][et], dacc[et], 0, 0, 0);
                        dacc[et] = __builtin_amdgcn_mfma_f32_16x16x32_bf16(ah, bl[k4][et], dacc[et], 0, 0, 0);
                        dacc[et] = __builtin_amdgcn_mfma_f32_16x16x32_bf16(al, bh[k4][et], dacc[et], 0, 0, 0); } }
            }
#pragma unroll
            for (int et = 0; et < 4; ++et)
#pragma unroll
                for (int j = 0; j < 4; ++j) lds_addf(&lg[(fq * 4 + j) * 64 + et * 16 + fr], dacc[et][j]);
        }
        __syncthreads();
#pragma unroll 1
        for (int rr = 0; rr < 2; ++rr) {
            const int lr = wave * 2 + rr;
            const float score = fast_sigmoid(lg[lr * 64 + lane]); const float biased = score + bias_l;
            int rk = 0;
#pragma unroll
            for (int o = 1; o < 8; ++o) { const int src = (lane & ~7) | ((lane + o) & 7); const float ov = __shfl(biased, src); rk += (ov > biased || (ov == biased && src < lane)) ? 1 : 0; }
            float g2 = rk < 2 ? biased : 0.f;
            g2 += __shfl_xor(g2, 1); g2 += __shfl_xor(g2, 2); g2 += __shfl_xor(g2, 4);
            int grk = 0; const int mygrp = lane >> 3;
#pragma unroll
            for (int gg = 0; gg < 8; ++gg) { const float ov = u2f((unsigned)__builtin_amdgcn_readlane((int)f2u(g2), gg * 8));
                grk += (gg != mygrp && (ov > g2 || (ov == g2 && gg < mygrp))) ? 1 : 0; }
            const float cand = grk < 4 ? biased : -__builtin_inff();
            int erk = 0;
#pragma unroll
            for (int e = 0; e < 64; ++e) { const float ov = u2f((unsigned)__builtin_amdgcn_readlane((int)f2u(cand), e)); erk += (e != lane && (ov > cand || (ov == cand && e < lane))) ? 1 : 0; }
            const bool selq = erk < 8;
            const float gsum = wave_sum(selq ? score : 0.f);
            gbuf[lr * 64 + lane] = score / gsum * 2.5f;
            const unsigned long long m = __ballot(selq);
            if (lane == 0) smask[lr] = m;
        }
        __syncthreads();
        if (wave == 0) {
            int n = 0;
#pragma unroll
            for (int tk = 0; tk < 16; ++tk) n += (int)((smask[tk] >> lane) & 1ull);
            unsigned pos = 0; if (n) pos = atomicAdd(&cnt[lane], (unsigned)n);
#pragma unroll
            for (int tk = 0; tk < 16; ++tk) { const unsigned long long m = smask[tk];
                if ((m >> lane) & 1ull) { const int tok = r0 + tk; const int k = __builtin_popcountll(m & ((1ull << lane) - 1ull));
                    TOKL[lane * T + pos] = tok; SLOT[tok * 8 + k] = (lane << 16) | (int)pos; GATE[tok * 8 + k] = gbuf[tk * 64 + lane]; ++pos; } }
        }
        __syncthreads();
    }
}

__device__ __forceinline__ void phase_ln2(const Frame& F, const float* g2, const float* b2, float* out) {
    const bf16_t* ACC2 = (const bf16_t*)(F.ws + WS_ACC2); const unsigned char* Y = F.ws + WS_Y; const int* SLOT = (const int*)(F.ws + WS_SLOT); const float* GATE = (const float*)(F.ws + WS_GATE);
    const unsigned* cnt = (const unsigned*)(F.ws + WS_CTL) + CW_CNT;
    LAS int* tstart = (LAS int*)(F.lds + LDS_AUX);
    if (F.tid == 0) { int acc = 0; for (int e = 0; e < NE; ++e) { tstart[e] = acc; acc += ((int)cnt[e] + 255) >> 8; } tstart[NE] = acc; tstart[NE + 1] = acc + T / 256; }
    __syncthreads();
    const int lane = F.lane;
    for (int row = F.gw; row < T; row += F.NGW) {
        f32x4 v[8];
        const u32x2* xr = (const u32x2*)(ACC2 + (size_t)row * D) + lane;
#pragma unroll
        for (int j = 0; j < 8; ++j) { const u32x2 w = xr[64 * j]; v[j] = (f32x4){bflo(w.x), bfhi(w.x), bflo(w.y), bfhi(w.y)}; }
        int si[8]; float gt[8];
        { const u32x4 s0 = *(const u32x4*)(SLOT + row * 8), s1 = *(const u32x4*)(SLOT + row * 8 + 4); const f32x4 g0 = *(const f32x4*)(GATE + row * 8), g1 = *(const f32x4*)(GATE + row * 8 + 4);
          si[0] = (int)s0.x; si[1] = (int)s0.y; si[2] = (int)s0.z; si[3] = (int)s0.w; si[4] = (int)s1.x; si[5] = (int)s1.y; si[6] = (int)s1.z; si[7] = (int)s1.w;
          gt[0] = g0[0]; gt[1] = g0[1]; gt[2] = g0[2]; gt[3] = g0[3]; gt[4] = g1[0]; gt[5] = g1[1]; gt[6] = g1[2]; gt[7] = g1[3]; }
#pragma unroll
        for (int kb = 0; kb < 3; ++kb) {
            unsigned w[3][8]; float g[3];
#pragma unroll
            for (int u = 0; u < 3; ++u) { const int k = kb * 3 + u; size_t yrow;
                if (k < 8) { yrow = (size_t)tstart[si[k] >> 16] * 256 + (si[k] & 0xffff); g[u] = gt[k] * Y8_INV; } else { yrow = (size_t)tstart[NE] * 256 + row; g[u] = Y8_INV; }
                const unsigned* yr = (const unsigned*)(Y + yrow * D) + lane;
#pragma unroll
                for (int j = 0; j < 8; ++j) w[u][j] = yr[64 * j]; }
#pragma unroll
            for (int u = 0; u < 3; ++u)
#pragma unroll
                for (int j = 0; j < 8; ++j) { const f32x2 lo = __builtin_amdgcn_cvt_pk_f32_fp8((int)w[u][j], false), hi = __builtin_amdgcn_cvt_pk_f32_fp8((int)w[u][j], true);
                    v[j][0] += g[u] * lo[0]; v[j][1] += g[u] * lo[1]; v[j][2] += g[u] * hi[0]; v[j][3] += g[u] * hi[1]; }
        }
        float s = 0.f;
#pragma unroll
        for (int j = 0; j < 8; ++j) s += (v[j][0] + v[j][1]) + (v[j][2] + v[j][3]);
        const float mean = wave_sum(s) * (1.f / D); float s2 = 0.f;
#pragma unroll
        for (int j = 0; j < 8; ++j) { v[j] = v[j] - mean; s2 += (v[j][0] * v[j][0] + v[j][1] * v[j][1]) + (v[j][2] * v[j][2] + v[j][3] * v[j][3]); }
        const float rstd = 1.0f / sqrtf(wave_sum(s2) * (1.f / D) + LN_EPS);
#pragma unroll
        for (int j = 0; j < 8; ++j) { const int c = 4 * lane + 256 * j; const f32x4 gg = *(const f32x4*)(g2 + c), bb = *(const f32x4*)(b2 + c);
            f32x4 y;
#pragma unroll
            for (int e = 0; e < 4; ++e) y[e] = v[j][e] * rstd * gg[e] + bb[e];
            *(f32x4*)(out + (size_t)row * D + c) = y; }
    }
}

constexpr int N_PHASES = 10;
__global__ void __launch_bounds__(NTHR, 2) fwd(Args args) {
    extern __shared__ __attribute__((aligned(16))) unsigned char lds_raw[];
    Frame F;
    F.lds = (LAS unsigned char*)lds_raw; F.tid = threadIdx.x; F.lane = F.tid & 63; F.wave = __builtin_amdgcn_readfirstlane(F.tid >> 6);
    F.G = gridDim.x; { const int bx = blockIdx.x; F.vcu = (F.G % 8 == 0) ? (bx % 8) * (F.G / 8) + bx / 8 : bx; }
    F.gw = blockIdx.x * NWAVES + F.wave; F.NGW = F.G * NWAVES; F.ws = args.ws;
    unsigned char* ws = args.ws;
    volatile LAS unsigned* MISC = (volatile LAS unsigned*)(F.lds + LDS_MISC);
    if (F.tid < 64) MISC[F.tid] = 0u;
    __syncthreads();
#if MK_N_LAUNCHES == 1
    XcdBarrier bar = xcd_barrier_post((unsigned*)(ws + WS_CTL) + CW_BAR, MISC + 8);
#define GRID_BAR() xcd_barrier(bar)
#else
#define GRID_BAR() do {} while (0)
#endif
    const int lo = args.ph_lo, hi = args.ph_hi;
#ifndef PHASE_MASK
#define PHASE_MASK 0x3ff
#endif
#define IN(k) (((PHASE_MASK >> (k)) & 1) && lo <= (k) && (k) < hi)
#define SEAM(k) do { if (IN(k) && IN((k) + 1)) GRID_BAR(); } while (0)

#ifndef PROBE_DOUBLE
#define PROBE_DOUBLE -1
#endif
#define PHASE(k, ...) do { if (IN(k)) { __VA_ARGS__ if (PROBE_DOUBLE == (k)) { GRID_BAR(); __VA_ARGS__ } SEAM(k); } } while (0)
    PHASE(0, { phase_convert(F, args); });
    PHASE(1, {
        { pg8::DenseSched S; S.init(ws + WS_XB, ws + WS_WIN, T, NIN_PAD, D, F.G, (int)blockIdx.x); EpiInProj E{ws}; pg8::gemm_phase(F.lds, S, E); }
        { pg8::DenseSched S; S.init(ws + WS_PB, ws + WS_WPE, T, D, PLE, F.G, (int)blockIdx.x); EpiPlain E{(bf16_t*)(ws + WS_PP), D}; pg8::gemm_phase(F.lds, S, E); }
    });
    const int wG = (int)F.G > 2 * NCONV ? (int)F.G - NCONV : (int)F.G; const bool is_conv = (int)blockIdx.x >= wG; const int ncw = ((int)F.G - wG) * NWAVES, cw = ((int)blockIdx.x - wG) * NWAVES + F.wave;
    PHASE(2, { if (is_conv) convert_range(args, ws, CV_P0_END, CV_SPLIT, cw, ncw, F.lane);
               else { phase_yconv(F, karg(3), (int)blockIdx.x, wG); phase_indexer(F, (int)blockIdx.x, wG); }
               if (wG == (int)F.G) convert_range(args, ws, CV_P0_END, CV_SPLIT, F.gw, F.NGW, F.lane); });
    PHASE(3, {
        { pg8::DenseSched S; S.init(ws + WS_YC, ws + WS_WB, T, D, CW, F.G, (int)blockIdx.x); EpiGate<false> E{(const bf16_t*)(ws + WS_SB), nullptr, (bf16_t*)(ws + WS_M1)}; pg8::gemm_phase(F.lds, S, E); }
        if (is_conv) convert_range(args, ws, CV_SPLIT, CV_N7, cw, ncw, F.lane);
#ifdef ATTN_V1
        else phase_attn_mfma(F, (int)blockIdx.x, wG);
#else
        else phase_attn_stream(F, (int)blockIdx.x, wG);
#endif
        if (wG == (int)F.G) convert_range(args, ws, CV_SPLIT, CV_N7, F.gw, F.NGW, F.lane);
    });
    PHASE(4, {
        pg8::DenseSched S; S.init(ws + WS_YA, ws + WS_WA, T, D, AW, F.G, (int)blockIdx.x); S.rowb = AW; EpiGate<true> E{(const bf16_t*)(ws + WS_SA), (const bf16_t*)(ws + WS_M1), (bf16_t*)(ws + WS_MG)};
        pg8::gemm_phase<EpiGate<true>, pg8::DenseSched, true, 0x79797979>(F.lds, S, E);
    });
    PHASE(5, {
        pg8::DenseSched S; S.init(ws + WS_MG, ws + WS_WO, T, D, D, F.G, (int)blockIdx.x); EpiResid E{karg(0), (bf16_t*)(ws + WS_PRE1)}; pg8::gemm_phase(F.lds, S, E);
    });
#ifdef PROBE_DOUBLE_P6
    if (IN(6)) { phase_ln1_route(F, karg(7), karg(8), karg(10)); GRID_BAR();
        if (blockIdx.x == 0 && F.tid < NE) ((unsigned*)(ws + WS_CTL) + CW_CNT)[F.tid] = 0u;
        GRID_BAR(); }
#endif
    PHASE(6, { phase_ln1_route(F, karg(7), karg(8), karg(10)); });
    PHASE(7, {
        LAS int* tstart = (LAS int*)(F.lds + LDS_AUX);
        const unsigned* cnt = (const unsigned*)(ws + WS_CTL) + CW_CNT;
        if (F.tid == 0) { int acc = 0; for (int e = 0; e < NE; ++e) { tstart[e] = acc; acc += ((int)cnt[e] + 255) >> 8; } tstart[NE] = acc; tstart[NE + 1] = acc + T / 256; }
        __syncthreads();
        { pg8::MoeSched<true> S; S.A = (const char*)(ws + WS_H18); S.Bt = (const char*)(ws + WS_W1); S.bstride = (size_t)1024 * D; S.K = D; S.rowb = D; S.npn = 4; S.tstart = tstart; S.cnt = (const int*)cnt; S.tokl = (const int*)(ws + WS_TOKL);
          S.total = __builtin_amdgcn_readfirstlane(tstart[NE + 1]) * 4; S.G = F.G; S.c = F.vcu; EpiSwiGlu E{ws + WS_HID}; pg8::gemm_phase<EpiSwiGlu, pg8::MoeSched<true>, true>(F.lds, S, E); }
        { pg8::DenseSched S; S.init(ws + WS_H18, ws + WS_WPG, T, D, D, F.G, (int)blockIdx.x); S.rowb = D; EpiPle E{(const bf16_t*)(ws + WS_H1B), (const bf16_t*)(ws + WS_PP), (bf16_t*)(ws + WS_ACC2)}; pg8::gemm_phase<EpiPle, pg8::DenseSched, true>(F.lds, S, E); }
    });
    PHASE(8, {
        LAS int* tstart = (LAS int*)(F.lds + LDS_AUX);
        const unsigned* cnt = (const unsigned*)(ws + WS_CTL) + CW_CNT;
        if (F.tid == 0) { int acc = 0; for (int e = 0; e < NE; ++e) { tstart[e] = acc; acc += ((int)cnt[e] + 255) >> 8; } tstart[NE] = acc; tstart[NE + 1] = acc + T / 256; }
        __syncthreads();
        pg8::MoeSched<false> S; S.A = (const char*)(ws + WS_HID); S.Bt = (const char*)(ws + WS_W2); S.bstride = (size_t)D * EFF; S.K = EFF; S.rowb = EFF; S.npn = 8; S.tstart = tstart; S.cnt = (const int*)cnt; S.tokl = nullptr;
        S.total = __builtin_amdgcn_readfirstlane(tstart[NE + 1]) * 8; S.G = F.G; S.c = F.vcu; EpiY8 E{ws + WS_Y, Y8_SCALE * W8_INV}; pg8::gemm_phase<EpiY8, pg8::MoeSched<false>, true>(F.lds, S, E);
    });
    PHASE(9, { phase_ln2(F, karg(19), karg(20), (float*)karg(21)); });
}

extern "C" void kernel_launch(void* const* d_in, const int* in_sizes, int n_in, void* d_out, int out_size, void* d_ws, size_t ws_size, hipStream_t stream) {
    static int grid = 0;
    if (!grid) {
        if (n_in != 21 || ws_size < WS_END) { fprintf(stderr, "kernel_launch: unexpected n_in %d / ws_size %zu (need %zu)\n", n_in, ws_size, (size_t)WS_END); grid = -1; return; }
        int dev = 0, cus = 0, per_cu = 0;
        hipGetDevice(&dev); hipDeviceGetAttribute(&cus, hipDeviceAttributeMultiprocessorCount, dev);
        if (hipFuncSetAttribute((const void*)fwd, hipFuncAttributeMaxDynamicSharedMemorySize, LDS_BYTES) != hipSuccess) { fprintf(stderr, "kernel_launch: hipFuncSetAttribute failed\n"); grid = -1; return; }
        hipOccupancyMaxActiveBlocksPerMultiprocessor(&per_cu, (const void*)fwd, NTHR, LDS_BYTES);
        if (per_cu < 1) fprintf(stderr, "kernel_launch: occupancy query says %d\n", per_cu);
        grid = cus;
    }
    if (grid <= 0) return;
    hipMemsetAsync((char*)d_ws + WS_CTL, 0, CTL_BYTES, stream);
    Args a{};
    for (int i = 0; i < 21; ++i) a.in[i] = (const float*)d_in[i];
    a.out = (float*)d_out; a.ws = (unsigned char*)d_ws;
#if MK_N_LAUNCHES == 1
    a.ph_lo = 0; a.ph_hi = N_PHASES;
    hipLaunchKernelGGL(fwd, dim3(grid), dim3(NTHR), LDS_BYTES, stream, a);
#else
    for (int p = 0; p < N_PHASES; ++p) { a.ph_lo = p; a.ph_hi = p + 1; hipLaunchKernelGGL(fwd, dim3(grid), dim3(NTHR), LDS_BYTES, stream, a); }
#endif
}
```
